# Optimizing an MI355X kernel written in HIP

```python
import jax, jax.numpy as jnp
from jax import lax
import numpy as np

D_MODEL = 1024
BATCH = 8
SEQ = 4096
DEPTH = 1

NSA_HEADS = 8
NSA_KV_HEADS = 2
NSA_HEAD_DIM = 64
NSA_GROUP = NSA_HEADS // NSA_KV_HEADS
CMP_BLOCK = 32
CMP_STRIDE = 16
CMP_HIDDEN = 256
SEL_BLOCK = 64
SEL_TOPN = 16
WINDOW = 512
Q_BLOCK = 128
MLSTM_HEADS = 4
MLSTM_HEAD_DIM = 128
MLSTM_CHUNK = 64
CONV_WIDTH = 4
NSA_WIDTH = NSA_HEADS * NSA_HEAD_DIM
MLSTM_WIDTH = MLSTM_HEADS * MLSTM_HEAD_DIM
MIX_WIDTH = NSA_WIDTH + MLSTM_WIDTH
KV_WIDTH = NSA_KV_HEADS * NSA_HEAD_DIM
IN_SPLITS = (NSA_WIDTH,) + (KV_WIDTH,) * 6 + (3 * NSA_HEADS,) + (MLSTM_WIDTH,) * 3 + (MLSTM_HEADS,) * 2
IN_WIDTH = sum(IN_SPLITS)
D_FF = -(-8 * D_MODEL // (3 * 256)) * 256
NORM_EPS = 1e-6
NEG = -1e30
FORCE = 1e9

kernel_name = 'hymba_nsa_mlstm_swiglu_alibi'


def rms_norm(x, g):
    xf = x.astype(jnp.float32)
    y = xf * lax.rsqrt(jnp.mean(xf * xf, axis=-1, keepdims=True) + NORM_EPS)
    return (y * g.astype(jnp.float32)).astype(x.dtype)


def alibi_slopes(n):
    return jnp.exp2(-8.0 * (jnp.arange(n, dtype=jnp.float32) + 1.0) / n)


def compress_blocks(a, pos, w1, w2):
    B, G, T, dh = a.shape
    r_seg = CMP_BLOCK // CMP_STRIDE
    nseg = T // CMP_STRIDE
    nc = nseg - r_seg + 1
    ab = a.reshape(B, G, nseg, CMP_STRIDE, dh)
    blocks = jnp.concatenate([ab[:, :, r:r + nc] for r in range(r_seg)], axis=3)
    flat = (blocks + pos).reshape(B, G, nc, CMP_BLOCK * dh)
    return jax.nn.gelu(flat @ w1) @ w2


def nsa_mixer(q, k_cmp, v_cmp, k_slc, v_slc, k_win, v_win, gate_logits,
              q_g, kc_g, ks_g, kw_g, pos, wk1, wk2, wv1, wv2):
    B, T, _ = q.shape
    G, R, dh = NSA_KV_HEADS, NSA_GROUP, NSA_HEAD_DIM
    f32 = jnp.float32
    scale = dh ** -0.5
    slopes = alibi_slopes(NSA_HEADS).reshape(G, R)
    t_pos = jnp.arange(T)
    qh = rms_norm(q.reshape(B, T, G, R, dh), q_g).transpose(0, 2, 3, 1, 4)

    def kv_heads(a):
        return a.reshape(B, T, G, dh).transpose(0, 2, 1, 3)

    kc = rms_norm(compress_blocks(kv_heads(k_cmp), pos, wk1, wk2), kc_g)
    vc = compress_blocks(kv_heads(v_cmp), pos, wv1, wv2)
    nc = kc.shape[2]
    blk_end = jnp.arange(nc) * CMP_STRIDE + CMP_BLOCK - 1
    dist_c = t_pos[:, None] - blk_end[None, :]
    valid_c = dist_c >= 0
    s_c = (jnp.einsum('bgrtd,bgcd->bgrtc', qh, kc).astype(f32) * scale
           - slopes[:, :, None, None] * dist_c.astype(f32))
    s_c = jnp.where(valid_c, s_c, NEG)
    p_c = jax.nn.softmax(s_c, axis=-1) * valid_c
    o_cmp = jnp.einsum('bgrtc,bgcd->bgrtd', p_c.astype(vc.dtype), vc)

    nsel = T // SEL_BLOCK
    topn = min(SEL_TOPN, nsel)
    cs = jnp.arange(nc) * CMP_STRIDE
    ss = jnp.arange(nsel) * SEL_BLOCK
    overlap = ((cs[:, None] < ss[None, :] + SEL_BLOCK) & (cs[:, None] + CMP_BLOCK > ss[None, :])).astype(f32)
    imp = jnp.einsum('bgtc,cn->bgtn', p_c.sum(axis=2), overlap)
    blk = jnp.arange(nsel)
    forced = (blk[None, :] == (t_pos // SEL_BLOCK)[:, None]) | (blk[None, :] == 0)
    future = ss[None, :] > t_pos[:, None]
    imp = jnp.where(forced, FORCE, jnp.where(future, -FORCE, imp))
    _, sel_idx = lax.top_k(imp, topn)

    ks_blocks = rms_norm(kv_heads(k_slc), ks_g).reshape(B, G, nsel, SEL_BLOCK, dh)
    vs_blocks = kv_heads(v_slc).reshape(B, G, nsel, SEL_BLOCK, dh)
    pad = ((0, 0), (0, 0), (WINDOW, 0), (0, 0))
    kw = jnp.pad(rms_norm(kv_heads(k_win), kw_g), pad)
    vw = jnp.pad(kv_heads(v_win), pad)
    bi = jnp.arange(B)[:, None, None, None]
    gi = jnp.arange(G)[None, :, None, None]
    sb_off = jnp.arange(SEL_BLOCK)
    w_off = jnp.arange(Q_BLOCK + WINDOW) - WINDOW
    slopes_sel = slopes[None, :, :, None, None, None]

    def block_fn(qb):
        t0 = qb * Q_BLOCK
        qq = lax.dynamic_slice_in_dim(qh, t0, Q_BLOCK, axis=3)
        tq = t0 + jnp.arange(Q_BLOCK)
        idx = lax.dynamic_slice_in_dim(sel_idx, t0, Q_BLOCK, axis=2)
        kg = ks_blocks[bi, gi, idx]
        vg = vs_blocks[bi, gi, idx]
        kpos = idx[..., None] * SEL_BLOCK + sb_off
        dist = (tq[None, None, :, None, None] - kpos)[:, :, None]
        s = (jnp.einsum('bgrqd,bgqnkd->bgrqnk', qq, kg).astype(f32) * scale
             - slopes_sel * dist.astype(f32))
        s = jnp.where(dist >= 0, s, NEG).reshape(B, G, R, Q_BLOCK, topn * SEL_BLOCK)
        p = jax.nn.softmax(s, axis=-1).astype(vg.dtype)
        o_s = jnp.einsum('bgrqk,bgqkd->bgrqd', p, vg.reshape(B, G, Q_BLOCK, topn * SEL_BLOCK, dh))
        kwb = lax.dynamic_slice_in_dim(kw, t0, Q_BLOCK + WINDOW, axis=2)
        vwb = lax.dynamic_slice_in_dim(vw, t0, Q_BLOCK + WINDOW, axis=2)
        wpos = t0 + w_off
        dist_w = tq[:, None] - wpos[None, :]
        valid_w = (dist_w >= 0) & (dist_w < WINDOW) & (wpos[None, :] >= 0)
        s_w = (jnp.einsum('bgrqd,bgkd->bgrqk', qq, kwb).astype(f32) * scale
               - slopes[:, :, None, None] * dist_w.astype(f32))
        s_w = jnp.where(valid_w, s_w, NEG)
        p_w = jax.nn.softmax(s_w, axis=-1).astype(vwb.dtype)
        o_w = jnp.einsum('bgrqk,bgkd->bgrqd', p_w, vwb)
        return o_s, o_w

    o_slc, o_win = lax.map(block_fn, jnp.arange(T // Q_BLOCK))

    def unblock(o):
        return o.transpose(1, 2, 3, 0, 4, 5).reshape(B, G, R, T, dh)

    gates = jax.nn.sigmoid(gate_logits.astype(f32).reshape(B, T, G, R, 3)).transpose(0, 2, 3, 1, 4)
    o = (gates[..., 0:1] * o_cmp.astype(f32) + gates[..., 1:2] * unblock(o_slc).astype(f32)
         + gates[..., 2:3] * unblock(o_win).astype(f32))
    return o.transpose(0, 3, 1, 2, 4).reshape(B, T, NSA_WIDTH).astype(q.dtype)


def causal_dwconv(x, w, b):
    C = x.shape[-1]
    y = lax.conv_general_dilated(x, w[:, None, :], window_strides=(1,), padding=[(CONV_WIDTH - 1, 0)],
                                 dimension_numbers=('NWC', 'WIO', 'NWC'), feature_group_count=C)
    return y + b


def mlstm_chunkwise(q, k, v, log_i, log_f):
    f32 = jnp.float32
    B, NH, T, dk = q.shape
    dv = v.shape[-1]
    L = MLSTM_CHUNK
    nch = T // L
    q = q.astype(f32).reshape(B, NH, nch, L, dk)
    k = k.astype(f32).reshape(B, NH, nch, L, dk)
    v = v.astype(f32).reshape(B, NH, nch, L, dv)
    log_i = log_i.reshape(B, NH, nch, L)
    log_f = log_f.reshape(B, NH, nch, L)
    b = jnp.cumsum(log_f, axis=-1)
    g = b[..., -1]
    w_end = g[..., None] - b + log_i

    def step(carry, xs):
        C, n, m = carry
        g_c, w_c, k_c, v_c = xs
        m_new = jnp.maximum(g_c + m, w_c.max(axis=-1))
        decay = jnp.exp(g_c + m - m_new)
        w = jnp.exp(w_c - m_new[..., None])
        C_new = decay[..., None, None] * C + jnp.einsum('bhl,bhlv,bhlk->bhvk', w, v_c, k_c)
        n_new = decay[..., None] * n + jnp.einsum('bhl,bhlk->bhk', w, k_c)
        return (C_new, n_new, m_new), (C, n, m)

    init = (jnp.zeros((B, NH, dv, dk), f32), jnp.zeros((B, NH, dk), f32), jnp.zeros((B, NH), f32))
    xs = (jnp.moveaxis(g, 2, 0), jnp.moveaxis(w_end, 2, 0), jnp.moveaxis(k, 2, 0), jnp.moveaxis(v, 2, 0))
    _, (C_prev, n_prev, m_prev) = lax.scan(step, init, xs)
    C_prev = jnp.moveaxis(C_prev, 0, 2)
    n_prev = jnp.moveaxis(n_prev, 0, 2)
    m_prev = jnp.moveaxis(m_prev, 0, 2)

    causal = jnp.tril(jnp.ones((L, L), dtype=bool))
    D = jnp.where(causal, b[..., :, None] - b[..., None, :] + log_i[..., None, :], NEG)
    m_inter = b + m_prev[..., None]
    m_out = jnp.maximum(m_inter, D.max(axis=-1))
    P = jnp.einsum('bhcld,bhcsd->bhcls', q, k) * jnp.exp(D - m_out[..., None])
    inter = jnp.exp(m_inter - m_out)
    num = (inter[..., None] * jnp.einsum('bhcld,bhcvd->bhclv', q, C_prev)
           + jnp.einsum('bhcls,bhcsv->bhclv', P, v))
    den = inter * jnp.einsum('bhcld,bhcd->bhcl', q, n_prev) + P.sum(axis=-1)
    h = num / jnp.maximum(jnp.abs(den), jnp.exp(-m_out))[..., None]
    return h.reshape(B, NH, T, dv)


def mlstm_mixer(u, v, o_pre, i_pre, f_pre, conv_w, conv_b, w_q, w_k, b_i, b_f, norm_g, skip):
    B, T, _ = u.shape
    NH, dm = MLSTM_HEADS, MLSTM_HEAD_DIM
    f32 = jnp.float32
    u_c = jax.nn.silu(causal_dwconv(u, conv_w, conv_b))
    uh = u_c.reshape(B, T, NH, dm)
    q = jnp.einsum('bthd,hde->bhte', uh, w_q)
    k = jnp.einsum('bthd,hde->bhte', uh, w_k) * (dm ** -0.5)
    vh = v.reshape(B, T, NH, dm).transpose(0, 2, 1, 3)
    log_i = (i_pre + b_i).astype(f32).transpose(0, 2, 1)
    log_f = jax.nn.log_sigmoid((f_pre + b_f).astype(f32)).transpose(0, 2, 1)
    h = mlstm_chunkwise(q, k, vh, log_i, log_f)
    h = h * jax.nn.sigmoid(o_pre.astype(f32).reshape(B, T, NH, dm).transpose(0, 2, 1, 3))
    h = rms_norm(h, norm_g[:, None, :])
    return h.transpose(0, 2, 1, 3).reshape(B, T, MLSTM_WIDTH).astype(u.dtype) + skip * u_c


def setup_inputs(seed: int = 0) -> dict:
    key = jax.random.key(seed)
    ks = jax.random.split(key, 25)
    L = DEPTH
    dh, dm, nh = NSA_HEAD_DIM, MLSTM_HEAD_DIM, MLSTM_HEADS

    def nrm(k, shape, scale):
        return jax.random.normal(k, shape, jnp.float32) * scale

    def gain(k, shape):
        return 1.0 + nrm(k, shape, 0.02)

    return {
        'x': nrm(ks[0], (BATCH, SEQ, D_MODEL), 1.0),
        'norm1_g': gain(ks[1], (L, D_MODEL)),
        'w_in': nrm(ks[2], (L, D_MODEL, IN_WIDTH), D_MODEL ** -0.5),
        'q_norm_g': gain(ks[3], (L, dh)),
        'kc_norm_g': gain(ks[4], (L, dh)),
        'ks_norm_g': gain(ks[5], (L, dh)),
        'kw_norm_g': gain(ks[6], (L, dh)),
        'cmp_pos': nrm(ks[7], (L, CMP_BLOCK, dh), 0.2),
        'w_ck1': nrm(ks[8], (L, CMP_BLOCK * dh, CMP_HIDDEN), (CMP_BLOCK * dh) ** -0.5),
        'w_ck2': nrm(ks[9], (L, CMP_HIDDEN, dh), CMP_HIDDEN ** -0.5),
        'w_cv1': nrm(ks[10], (L, CMP_BLOCK * dh, CMP_HIDDEN), (CMP_BLOCK * dh) ** -0.5),
        'w_cv2': nrm(ks[11], (L, CMP_HIDDEN, dh), CMP_HIDDEN ** -0.5),
        'conv_w': nrm(ks[12], (L, CONV_WIDTH, MLSTM_WIDTH), CONV_WIDTH ** -0.5),
        'conv_b': nrm(ks[13], (L, MLSTM_WIDTH), 0.01),
        'w_mq': nrm(ks[14], (L, nh, dm, dm), dm ** -0.5),
        'w_mk': nrm(ks[15], (L, nh, dm, dm), dm ** -0.5),
        'b_i': nrm(ks[16], (L, nh), 0.1),
        'b_f': jnp.linspace(3.0, 6.0, nh, dtype=jnp.float32)[None, :] + nrm(ks[17], (L, nh), 0.1),
        'mlstm_norm_g': gain(ks[18], (L, nh, dm)),
        'mlstm_skip': gain(ks[19], (L, MLSTM_WIDTH)),
        'w_out': nrm(ks[20], (L, MIX_WIDTH, D_MODEL), MIX_WIDTH ** -0.5),
        'norm2_g': gain(ks[21], (L, D_MODEL)),
        'w_gate': nrm(ks[22], (L, D_MODEL, D_FF), D_MODEL ** -0.5),
        'w_up': nrm(ks[23], (L, D_MODEL, D_FF), D_MODEL ** -0.5),
        'w_down': nrm(ks[24], (L, D_FF, D_MODEL), D_FF ** -0.5),
    }


def reference(x, norm1_g, w_in, q_norm_g, kc_norm_g, ks_norm_g, kw_norm_g, cmp_pos,
              w_ck1, w_ck2, w_cv1, w_cv2, conv_w, conv_b, w_mq, w_mk, b_i, b_f,
              mlstm_norm_g, mlstm_skip, w_out, norm2_g, w_gate, w_up, w_down):
    offsets = [int(o) for o in np.cumsum(IN_SPLITS)[:-1]]
    for l in range(DEPTH):
        h = rms_norm(x, norm1_g[l])
        proj = h @ w_in[l]
        (q, k_cmp, v_cmp, k_slc, v_slc, k_win, v_win, gate_logits,
         u, v_m, o_pre, i_pre, f_pre) = jnp.split(proj, offsets, axis=-1)
        y_nsa = nsa_mixer(q, k_cmp, v_cmp, k_slc, v_slc, k_win, v_win, gate_logits,
                          q_norm_g[l], kc_norm_g[l], ks_norm_g[l], kw_norm_g[l], cmp_pos[l],
                          w_ck1[l], w_ck2[l], w_cv1[l], w_cv2[l])
        y_mem = mlstm_mixer(u, v_m, o_pre, i_pre, f_pre, conv_w[l], conv_b[l], w_mq[l], w_mk[l],
                            b_i[l], b_f[l], mlstm_norm_g[l], mlstm_skip[l])
        x = x + jnp.concatenate([y_nsa, y_mem], axis=-1) @ w_out[l]
        h2 = rms_norm(x, norm2_g[l])
        x = x + (jax.nn.silu(h2 @ w_gate[l]) * (h2 @ w_up[l])) @ w_down[l]
    return x
```

```cpp
#include <hip/hip_runtime.h>
#include <hip/hip_cooperative_groups.h>
#include <cstdio>
#include <cstdint>
namespace cg = cooperative_groups;

#define LAS __attribute__((address_space(3)))
typedef unsigned short bf16_t;
typedef short bf16x8 __attribute__((ext_vector_type(8)));
typedef float f32x4 __attribute__((ext_vector_type(4)));
typedef float f32x2 __attribute__((ext_vector_type(2)));
typedef unsigned u32x4 __attribute__((ext_vector_type(4)));
typedef unsigned u32x2 __attribute__((ext_vector_type(2)));

constexpr int NB = 8, T = 4096, DM = 1024, M = NB * T, LDP = 3072, FF = 2816;
constexpr int CQ = 0, CKC = 512, CVC = 640, CKS = 768, CVS = 896, CKW = 1024, CVW = 1152, CG = 1280, CU = 1304, CVM = 1816, CO = 2328, CI = 2840, CF = 2844, INW = 2848;
constexpr float EPS = 1e-6f, LOG2E = 1.4426950408889634f;

constexpr size_t al(size_t x) { return (x + 255) & ~(size_t)255; }
constexpr size_t O_CTL = 0;
constexpr size_t O_WTIN = 65536;
constexpr size_t O_WTOUT = O_WTIN + al((size_t)LDP * DM * 2);
constexpr size_t O_WTGU = O_WTOUT + al((size_t)DM * DM * 2);
constexpr size_t O_WTDN = O_WTGU + al((size_t)2 * FF * DM * 2);
constexpr size_t O_WTC1 = O_WTDN + al((size_t)DM * FF * 2);
constexpr size_t O_WTC2 = O_WTC1 + al((size_t)2 * 256 * 2048 * 2);
constexpr size_t O_WTMQK = O_WTC2 + al((size_t)2 * 64 * 256 * 2);
constexpr size_t O_POSP = O_WTMQK + al((size_t)4 * 256 * 128 * 2);
constexpr size_t O_POSB = O_POSP + al((size_t)64 * 512 * 4);
constexpr size_t O_SSQ = O_POSB + al((size_t)512 * 4);
constexpr size_t O_DEN = O_SSQ + al((size_t)M * 16 * 4);
constexpr size_t O_KC = O_DEN + al((size_t)32 * T * 4);
constexpr size_t O_VCT = O_KC + al((size_t)16 * 256 * 64 * 2);
constexpr size_t O_HC = O_VCT + al((size_t)16 * 64 * 256 * 2);
constexpr size_t O_XN = O_HC + al((size_t)32 * 256 * 256 * 2);
constexpr size_t O_PROJ = O_XN + al((size_t)M * DM * 2);
constexpr size_t O_UC = O_PROJ + al((size_t)(M + 64) * LDP * 2);
constexpr size_t O_KSN = O_UC + al((size_t)M * 512 * 2);
constexpr size_t O_KWN = O_KSN + al((size_t)16 * T * 64 * 2);
constexpr size_t O_VST = O_KWN + al((size_t)16 * T * 64 * 2);
constexpr size_t O_VWT = O_VST + al((size_t)16 * T * 64 * 2);
constexpr size_t O_MVT = O_VWT + al((size_t)16 * T * 64 * 2);
constexpr size_t O_MKT = O_MVT + al((size_t)32 * 128 * T * 2);
constexpr size_t O_Y = O_MKT + al((size_t)32 * 128 * T * 2);
constexpr size_t O_PB = O_Y + al((size_t)M * DM * 2);
constexpr size_t O_GT = O_PB + al((size_t)32 * 64 * 4 * 2 * 64 * 16);
constexpr size_t O_END = O_GT + al((size_t)32 * 64 * 3 * 64 * 4);
constexpr size_t OUT_MQK = (size_t)M * 512 * 4;

constexpr int LDS_BYTES = 131072 + 4096;
constexpr int N_ML = 288, N_NSA = 4096;

struct KParams { const float* in[25]; float* out; unsigned char* ws; };

__device__ __forceinline__ float bf2f(unsigned short h) { return __uint_as_float(((unsigned)h) << 16); }
__device__ __forceinline__ unsigned cvt_pk(float lo, float hi) { unsigned r; asm("v_cvt_pk_bf16_f32 %0, %1, %2" : "=v"(r) : "v"(lo), "v"(hi)); return r; }
__device__ __forceinline__ unsigned short f2bf(float f) { return (unsigned short)(cvt_pk(f, 0.f) & 0xffffu); }
__device__ __forceinline__ void unpack8(const u32x4 w, float* f) {
#pragma unroll
    for (int i = 0; i < 4; ++i) { f[2 * i] = __uint_as_float(w[i] << 16); f[2 * i + 1] = __uint_as_float(w[i] & 0xffff0000u); }
}
__device__ __forceinline__ bf16x8 pack8(const float* f) {
    u32x4 w; w.x = cvt_pk(f[0], f[1]); w.y = cvt_pk(f[2], f[3]); w.z = cvt_pk(f[4], f[5]); w.w = cvt_pk(f[6], f[7]);
    return __builtin_bit_cast(bf16x8, w);
}
__device__ __forceinline__ float sigmoidf_(float x) { return 1.0f / (1.0f + __expf(-x)); }
__device__ __forceinline__ float siluf_(float x) { return x * sigmoidf_(x); }
__device__ __forceinline__ float gelu_tanh(float x) { const float u = 0.7978845608028654f * (x + 0.044715f * x * x * x); const float e = __expf(2.0f * u); const float th = 1.0f - 2.0f / (e + 1.0f); return 0.5f * x * (1.0f + th); }
#define LDS_WAIT() asm volatile("s_waitcnt lgkmcnt(0)" ::: "memory")
#define MFMA16(a, b, c) __builtin_amdgcn_mfma_f32_16x16x32_bf16((a), (b), (c), 0, 0, 0)

namespace pg8 {
constexpr int BM = 256, BK = 64, HALF = 128, HTB = HALF * BK * 2, STAGE_BYTES = 8 * HTB;
__device__ __forceinline__ int lds_byte(int r, int c) { const int st = (r >> 4) * 2 + (c >> 5), rr = r & 15, cc = c & 31, ob = rr * 64 + cc * 2; return st * 1024 + (ob ^ (((ob >> 9) & 1) << 5)); }
__device__ __forceinline__ void stage_rc(int b, int& R, int& C) { const int st = b / 1024, sb = b % 1024, swz = sb ^ (((sb >> 9) & 1) << 5); R = (st >> 1) * 16 + swz / 64; C = (st & 1) * 32 + (swz % 64) / 2; }
__device__ __forceinline__ int perm32(int rho) { const int n = rho >> 4, i = rho & 15; return 8 * (i >> 2) + 4 * n + (i & 3); }
struct Unit { int pm, pn; const char* A; const char* B; };
struct Cfg { int K, lda, ldb, kstepA, kstepB; };

template <class Epi, class Sched>
__device__ __forceinline__ void gemm_phase(LAS unsigned char* lds, const Cfg g, const Sched& S, const Epi& E) {
    int tid = threadIdx.x; asm volatile("" : "+v"(tid)); const int wid = __builtin_amdgcn_readfirstlane(tid >> 6), lane = tid & 63, wr = wid >> 2, wc = wid & 3, fr = lane & 15, fq = lane >> 4;
    const int nt = g.K / BK;
    unsigned voffA[2], voffB[2];
#pragma unroll
    for (int i = 0; i < 2; ++i) { int R, C; stage_rc(tid * 16 + i * 8192, R, C); const int Rb = Epi::PERM ? ((R & ~31) + perm32(R & 31)) : R;
        voffA[i] = (unsigned)(R * g.lda + C) * 2u; voffB[i] = (unsigned)(Rb * g.ldb + C) * 2u; }
    const size_t kstepA = (size_t)g.kstepA, kstepB = (size_t)g.kstepB;
    const size_t hstepA = (size_t)HALF * g.lda * 2, hstepB = (size_t)HALF * g.ldb * 2;
    const unsigned ldsw = (unsigned)wid * 1024u;
    const int aoff = lds_byte(wr * 64 + fr, fq * 8), boff = lds_byte(wc * 32 + fr, fq * 8);
#define PG8_SA(b, h) (((b) * 2 + (h)) * HTB)
#define PG8_SB(b, h) ((4 + (b) * 2 + (h)) * HTB)
#define PG8_STAGE(bufoff, gbase, voff) do { _Pragma("unroll") for (int _i = 0; _i < 2; ++_i) \
        __builtin_amdgcn_global_load_lds((const unsigned*)((const char*)(gbase) + (voff)[_i]), (LAS unsigned*)(lds + (bufoff) + ldsw + _i * 8192), 16, 0, 0); } while (0)
#define PG8_LDA(dst, b, h) do { _Pragma("unroll") for (int m = 0; m < 4; ++m) _Pragma("unroll") for (int k = 0; k < 2; ++k) dst[m][k] = *(const LAS bf16x8*)(lds + PG8_SA(b, h) + aoff + m * 2048 + k * 1024); } while (0)
#define PG8_LDB(dst, b, h) do { _Pragma("unroll") for (int n = 0; n < 2; ++n) _Pragma("unroll") for (int k = 0; k < 2; ++k) dst[n][k] = *(const LAS bf16x8*)(lds + PG8_SB(b, h) + boff + n * 2048 + k * 1024); } while (0)
#define PG8_MMA(ai, bj, At, Bt) do { __builtin_amdgcn_s_setprio(1); _Pragma("unroll") for (int m = 0; m < 4; ++m) _Pragma("unroll") for (int n = 0; n < 2; ++n) _Pragma("unroll") for (int k = 0; k < 2; ++k) \
        acc[ai][bj][m][n] = __builtin_amdgcn_mfma_f32_16x16x32_bf16(Bt[n][k], At[m][k], acc[ai][bj][m][n], 0, 0, 0); __builtin_amdgcn_s_setprio(0); } while (0)
#define PG8_WAIT_V(n) asm volatile("s_waitcnt vmcnt(" #n ")" ::: "memory")
#define PG8_WAIT_L(n) asm volatile("s_waitcnt lgkmcnt(" #n ")" ::: "memory")
#define PG8_BAR __builtin_amdgcn_s_barrier()
#define PG8_SCHED __builtin_amdgcn_sched_barrier(0)
    Unit cur, nxt; int ui = 0;
    if (!S.next(0, cur)) return;
    f32x4 acc[2][2][4][2];
#pragma unroll
    for (int a = 0; a < 2; ++a)
#pragma unroll
        for (int b = 0; b < 2; ++b)
#pragma unroll
            for (int m = 0; m < 4; ++m)
#pragma unroll
                for (int n = 0; n < 2; ++n) acc[a][b][m][n] = (f32x4){0.f, 0.f, 0.f, 0.f};
    bf16x8 At[4][2], B0[2][2], B1[2][2];
    const char* cA = cur.A; const char* cB = cur.B;
    PG8_STAGE(PG8_SB(0, 0), cB, voffB); PG8_STAGE(PG8_SB(0, 1), cB + hstepB, voffB); PG8_STAGE(PG8_SA(0, 0), cA, voffA); PG8_STAGE(PG8_SA(0, 1), cA + hstepA, voffA);
    if (wr == 1) PG8_BAR;
    PG8_WAIT_V(2); PG8_BAR;
    PG8_STAGE(PG8_SB(1, 0), cB + kstepB, voffB); PG8_STAGE(PG8_SA(1, 0), cA + kstepA, voffA); PG8_STAGE(PG8_SB(1, 1), cB + hstepB + kstepB, voffB);
    PG8_WAIT_V(6); PG8_BAR;
    for (;;) {
        const bool has_next = S.next(ui + 1, nxt);
        const char* nA = has_next ? nxt.A : cA; const char* nB = has_next ? nxt.B : cB;
        for (int t = 0; t < nt; t += 2) {
            const bool last = (t == nt - 2);
            const char* a1 = cA + (size_t)(t + 1) * kstepA;
            const char* a2 = last ? nA : cA + (size_t)(t + 2) * kstepA; const char* b2 = last ? nB : cB + (size_t)(t + 2) * kstepB;
            const char* a3 = a2 + kstepA; const char* b3 = b2 + kstepB;
            PG8_LDB(B0, 0, 0); PG8_LDB(B1, 0, 1); PG8_SCHED; PG8_LDA(At, 0, 0); PG8_STAGE(PG8_SA(1, 1), a1 + hstepA, voffA);
            PG8_WAIT_V(8); PG8_WAIT_L(0); PG8_BAR; PG8_MMA(0, 0, At, B0); PG8_MMA(0, 1, At, B1); PG8_BAR; PG8_SCHED;
            PG8_LDA(At, 0, 1); PG8_STAGE(PG8_SB(0, 0), b2, voffB); PG8_STAGE(PG8_SB(0, 1), b2 + hstepB, voffB); PG8_STAGE(PG8_SA(0, 0), a2, voffA);
            PG8_WAIT_V(8); PG8_WAIT_L(0); PG8_BAR; PG8_MMA(1, 0, At, B0); PG8_MMA(1, 1, At, B1); PG8_BAR; PG8_SCHED;
            PG8_LDB(B0, 1, 0); PG8_LDB(B1, 1, 1); PG8_SCHED; PG8_LDA(At, 1, 0); PG8_STAGE(PG8_SA(0, 1), a2 + hstepA, voffA);
            PG8_WAIT_V(8); PG8_WAIT_L(0); PG8_BAR; PG8_MMA(0, 0, At, B0); PG8_MMA(0, 1, At, B1); PG8_BAR; PG8_SCHED;
            PG8_LDA(At, 1, 1); PG8_STAGE(PG8_SB(1, 0), b3, voffB); PG8_STAGE(PG8_SB(1, 1), b3 + hstepB, voffB); PG8_STAGE(PG8_SA(1, 0), a3, voffA);
            PG8_WAIT_V(8); PG8_WAIT_L(0); PG8_BAR; PG8_MMA(1, 0, At, B0); PG8_MMA(1, 1, At, B1); PG8_BAR; PG8_SCHED;
        }
        if (wr == 0) PG8_BAR;
        E(acc, cur, wr, wc, fr, fq);
        if (!has_next) break;
#pragma unroll
        for (int a = 0; a < 2; ++a)
#pragma unroll
            for (int b = 0; b < 2; ++b)
#pragma unroll
                for (int m = 0; m < 4; ++m)
#pragma unroll
                    for (int n = 0; n < 2; ++n) acc[a][b][m][n] = (f32x4){0.f, 0.f, 0.f, 0.f};
        cur = nxt; cA = nA; cB = nB; ++ui;
        if (wr == 1) PG8_BAR;
    }
    PG8_WAIT_V(0);
    PG8_BAR;
#undef PG8_SA
#undef PG8_SB
#undef PG8_STAGE
#undef PG8_LDA
#undef PG8_LDB
#undef PG8_MMA
#undef PG8_WAIT_V
#undef PG8_WAIT_L
#undef PG8_BAR
#undef PG8_SCHED
}

struct Sched2D {
    const char* A; const char* B; size_t tA, tB; int nM, nN, nwg, G, c;
    __device__ void init(const void* A_, const void* B_, size_t tA_, size_t tB_, int nM_, int nN_, int G_, int c_) { A = (const char*)A_; B = (const char*)B_; tA = tA_; tB = tB_; nM = nM_; nN = nN_; nwg = nM * nN; G = G_; c = c_; }
    __device__ bool next(int i, Unit& u) const {
        const long L = (long)i * G + c; if (L >= nwg) return false;
        int wgid = (int)L; { const int q = nwg / 8, r = nwg % 8, xcd = wgid % 8, off = wgid / 8; wgid = (xcd < r ? xcd * (q + 1) : r * (q + 1) + (xcd - r) * q) + off; }
        const int nig = 8 * nN, gid = wgid / nig, fm = gid * 8, gsz = (nM - fm) < 8 ? (nM - fm) : 8;
        u.pm = fm + ((wgid % nig) % gsz); u.pn = (wgid % nig) / gsz; u.A = A + (size_t)u.pm * tA; u.B = B + (size_t)u.pn * tB; return true;
    }
};
}

template <int ACT> struct EpiBf16 {
    static constexpr bool PERM = true;
    bf16_t* O; int ldc; const float* bias;
    __device__ __forceinline__ void operator()(const f32x4 (&acc)[2][2][4][2], const pg8::Unit& u, int wr, int wc, int fr, int fq) const {
        const int row0 = u.pm * 256 + wr * 64 + fr, col0 = u.pn * 256 + wc * 32 + 8 * fq;
#pragma unroll
        for (int ai = 0; ai < 2; ++ai)
#pragma unroll
            for (int m = 0; m < 4; ++m) { bf16_t* rowp = O + (size_t)(row0 + ai * 128 + m * 16) * ldc + col0;
#pragma unroll
                for (int bj = 0; bj < 2; ++bj) { f32x4 v0 = acc[ai][bj][m][0], v1 = acc[ai][bj][m][1];
                    if (ACT == 1) { const float* bp = bias + (u.pm >> 4) * 256 + wc * 32 + 8 * fq + bj * 128;
#pragma unroll
                        for (int e = 0; e < 4; ++e) { v0[e] = gelu_tanh(v0[e] + bp[e]); v1[e] = gelu_tanh(v1[e] + bp[4 + e]); } }
                    u32x4 w; w.x = cvt_pk(v0[0], v0[1]); w.y = cvt_pk(v0[2], v0[3]); w.z = cvt_pk(v1[0], v1[1]); w.w = cvt_pk(v1[2], v1[3]);
                    *(u32x4*)(rowp + bj * 128) = w; } }
    }
};
struct EpiOut {
    static constexpr bool PERM = false;
    const float* X; float* O; bf16_t* XB; float* SSQ;
    __device__ __forceinline__ void operator()(const f32x4 (&acc)[2][2][4][2], const pg8::Unit& u, int wr, int wc, int fr, int fq) const {
        const int col0 = u.pn * 256 + wc * 32 + 4 * fq;
#pragma unroll
        for (int ai = 0; ai < 2; ++ai)
#pragma unroll
            for (int m = 0; m < 4; ++m) { const int row = u.pm * 256 + ai * 128 + wr * 64 + m * 16 + fr; const size_t off = (size_t)row * DM + col0; float ss = 0.f;
#pragma unroll
                for (int bj = 0; bj < 2; ++bj)
#pragma unroll
                    for (int n = 0; n < 2; ++n) { const f32x4 xv = *(const f32x4*)(X + off + bj * 128 + n * 16); const f32x4 v = xv + acc[ai][bj][m][n];
                        *(f32x4*)(O + off + bj * 128 + n * 16) = v; u32x2 w; w.x = cvt_pk(v[0], v[1]); w.y = cvt_pk(v[2], v[3]); *(u32x2*)(XB + off + bj * 128 + n * 16) = w;
                        ss += (v[0] * v[0] + v[1] * v[1]) + (v[2] * v[2] + v[3] * v[3]); }
                ss += __shfl_xor(ss, 16); ss += __shfl_xor(ss, 32);
                if (fq == 0) SSQ[(size_t)row * 16 + u.pn * 4 + wc] = ss; }
    }
};
struct EpiGU {
    static constexpr bool PERM = true;
    bf16_t* H; const float* SSQ;
    __device__ __forceinline__ void operator()(const f32x4 (&acc)[2][2][4][2], const pg8::Unit& u, int wr, int wc, int fr, int fq) const {
        const int hc0 = u.pn * 128 + wc * 16 + 4 * fq;
#pragma unroll
        for (int ai = 0; ai < 2; ++ai)
#pragma unroll
            for (int m = 0; m < 4; ++m) { const int row = u.pm * 256 + ai * 128 + wr * 64 + m * 16 + fr;
                const f32x4* sp = (const f32x4*)(SSQ + (size_t)row * 16); const f32x4 s0 = sp[0], s1 = sp[1], s2 = sp[2], s3 = sp[3];
                const float ss = ((s0[0] + s0[1]) + (s0[2] + s0[3])) + ((s1[0] + s1[1]) + (s1[2] + s1[3])) + ((s2[0] + s2[1]) + (s2[2] + s2[3])) + ((s3[0] + s3[1]) + (s3[2] + s3[3]));
                const float rs = rsqrtf(ss * (1.0f / DM) + EPS);
#pragma unroll
                for (int bj = 0; bj < 2; ++bj) { const f32x4 gv = acc[ai][bj][m][0] * rs, uv = acc[ai][bj][m][1] * rs; float h[4];
#pragma unroll
                    for (int e = 0; e < 4; ++e) h[e] = siluf_(gv[e]) * uv[e];
                    u32x2 w; w.x = cvt_pk(h[0], h[1]); w.y = cvt_pk(h[2], h[3]); *(u32x2*)(H + (size_t)row * FF + hc0 + bj * 64) = w; } }
    }
};
struct EpiDown {
    static constexpr bool PERM = false;
    float* O;
    __device__ __forceinline__ void operator()(const f32x4 (&acc)[2][2][4][2], const pg8::Unit& u, int wr, int wc, int fr, int fq) const {
        const int col0 = u.pn * 256 + wc * 32 + 4 * fq;
#pragma unroll
        for (int ai = 0; ai < 2; ++ai)
#pragma unroll
            for (int m = 0; m < 4; ++m) { const int row = u.pm * 256 + ai * 128 + wr * 64 + m * 16 + fr; const size_t off = (size_t)row * DM + col0;
#pragma unroll
                for (int bj = 0; bj < 2; ++bj)
#pragma unroll
                    for (int n = 0; n < 2; ++n) { float* p = O + off + bj * 128 + n * 16; const f32x4 xv = *(const f32x4*)p; *(f32x4*)p = xv + acc[ai][bj][m][n]; } }
    }
};
struct SchedCmp {
    const char* proj; const char* wt; int ncu, c;
    __device__ bool next(int i, pg8::Unit& u) const { if (c >= ncu) return false; const int L = i * ncu + c; if (L >= 32) return false;
        const int kv = L >> 4, g = (L >> 3) & 1, b = L & 7; u.pm = L; u.pn = 0;
        u.A = proj + ((size_t)b * T * LDP + (kv ? CVC : CKC) + g * 64) * 2; u.B = wt + (size_t)kv * 256 * 2048 * 2; return true; }
};
struct SchedMqk {
    const char* uc; const char* wt; int first, G, c;
    __device__ bool next(int i, pg8::Unit& u) const { if (c < first) return false; const int L = i * (G - first) + (c - first); if (L >= 512) return false;
        const int h = L >> 7, pm = L & 127; u.pm = pm; u.pn = h; u.A = uc + ((size_t)pm * 256 * 512 + h * 128) * 2; u.B = wt + (size_t)h * 256 * 128 * 2; return true; }
};

__device__ __forceinline__ void transpose_item(const float* W, int N, bf16_t* WT, int ldt, int row_off, int mode, const float* ks, float mul, LAS float* scr, int item, int lane) {
    const int nblk = N / 32, kb = item / nblk, nb = item % nblk, k0 = 64 * kb, n0 = 32 * nb;
#pragma unroll 8
    for (int i = 0; i < 32; ++i) { const int kk = 2 * i + (lane >> 5); float v = W[(size_t)(k0 + kk) * N + n0 + (lane & 31)] * mul; if (ks) v *= ks[k0 + kk]; scr[kk * 33 + (lane & 31)] = v; }
    LDS_WAIT();
    const int c = lane & 7;
#pragma unroll
    for (int j = 0; j < 4; ++j) { const int n = n0 + (lane >> 3) + 8 * j; const LAS float* s = scr + (8 * c) * 33 + (n - n0);
        u32x4 o; o.x = cvt_pk(s[0 * 33], s[1 * 33]); o.y = cvt_pk(s[2 * 33], s[3 * 33]); o.z = cvt_pk(s[4 * 33], s[5 * 33]); o.w = cvt_pk(s[6 * 33], s[7 * 33]);
        const int dst = mode == 0 ? row_off + n : ((n >> 2) * 8 + (n & 3) + (mode == 2 ? 4 : 0));
        *(u32x4*)(WT + (size_t)dst * ldt + k0 + 8 * c) = o; }
    LDS_WAIT();
}
__device__ __forceinline__ void tr64(const bf16_t* src, size_t lds_, bf16_t* dst, size_t ldd, LAS bf16_t* L, int lane, int fragmajor = 0, int tti = 0) {
#pragma unroll
    for (int i = 0; i < 8; ++i) { const int row = i * 8 + (lane >> 3), ch = lane & 7; const u32x4 w = *(const u32x4*)(src + (size_t)row * lds_ + 8 * ch);
#pragma unroll
        for (int e = 0; e < 4; ++e) { L[(8 * ch + 2 * e) * 72 + row] = (bf16_t)(w[e] & 0xffffu); L[(8 * ch + 2 * e + 1) * 72 + row] = (bf16_t)(w[e] >> 16); } }
    LDS_WAIT();
#pragma unroll
    for (int i = 0; i < 8; ++i) { const int c = i * 8 + (lane >> 3), ch = lane & 7; const u32x4 w = *(const LAS u32x4*)(L + c * 72 + 8 * ch);
        if (!fragmajor) *(u32x4*)(dst + (size_t)c * ldd + 8 * ch) = w;
        else if (fragmajor == 1) *(u32x4*)(dst + ((size_t)(((tti * 2 + (ch >> 2)) * 4 + (c >> 4)) * 64 + (ch & 3) * 16 + (c & 15))) * 8) = w;
        else *(u32x4*)(dst + ((size_t)((((tti * 8 + (fragmajor >> 8) * 4 + (c >> 4)) * 2 + (ch >> 2)) * 64) + (ch & 3) * 16 + (c & 15))) * 8) = w; }
    LDS_WAIT();
}
__device__ __forceinline__ float wave_sum(float v) {
#pragma unroll
    for (int o = 1; o < 64; o <<= 1) v += __shfl_xor(v, o);
    return v;
}

__device__ __forceinline__ float scan_sum(float v, int lane) {
#pragma unroll
    for (int d = 1; d < 64; d <<= 1) { const float t = __shfl_up(v, d); if (lane >= d) v += t; }
    return v;
}
__device__ __forceinline__ float scan_max(float v, int lane) {
#pragma unroll
    for (int d = 1; d < 64; d <<= 1) { const float t = __shfl_up(v, d); if (lane >= d) v = fmaxf(v, t); }
    return v;
}
__device__ __forceinline__ bf16x8 ld2x8(const bf16_t* p) {
    const u32x2 lo = *(const u32x2*)p, hi = *(const u32x2*)(p + 16); u32x4 w; w.x = lo.x; w.y = lo.y; w.z = hi.x; w.w = hi.y; return __builtin_bit_cast(bf16x8, w);
}

__device__ __forceinline__ void mlstm_ploc(const KParams& P, int it, int lane) {
    asm volatile("" : "+v"(lane));
    const int fr = lane & 15, fq = lane >> 4;
    const int bh = it >> 6, c = it & 63, b = bh >> 2, h = bh & 3, tc = c * 64;
    const bf16_t* proj = (const bf16_t*)(P.ws + O_PROJ);
    const size_t grow = (size_t)(b * T + tc + lane) * LDP;
    const float li = bf2f(proj[grow + CI + h]) + P.in[16][h];
    const float fz = bf2f(proj[grow + CF + h]) + P.in[17][h];
    const float lf = fminf(fz, 0.f) - log1pf(__expf(-fabsf(fz)));
    const float bc = scan_sum(lf, lane), a = li - bc, cm = scan_max(a, lane);
    { float* GT = (float*)(P.ws + O_GT) + (size_t)it * 192; GT[lane] = a; GT[64 + lane] = bc; GT[128 + lane] = cm; }
    const bf16_t* Qb = (const bf16_t*)((const char*)P.out + OUT_MQK) + (size_t)(b * T + tc) * 1024 + h * 256;
    bf16x8* PB = (bf16x8*)(P.ws + O_PB) + (size_t)it * 4 * 2 * 64;
    bf16x8* QF = (bf16x8*)(P.ws + O_XN) + (size_t)it * 4 * 4 * 64;
    const f32x4 zero4 = {0.f, 0.f, 0.f, 0.f};
    float as_[2][8];
#pragma unroll
    for (int j2 = 0; j2 < 2; ++j2)
#pragma unroll
        for (int e = 0; e < 8; ++e) as_[j2][e] = __shfl(a, 32 * j2 + 8 * fq + e);
#pragma unroll 1
    for (int lt = 0; lt < 4; ++lt) {
        const int l = 16 * lt + fr; const float cml = __shfl(cm, l);
        bf16x8 Qf[4];
#pragma unroll
        for (int j = 0; j < 4; ++j) { Qf[j] = *(const bf16x8*)(Qb + (size_t)l * 1024 + 32 * j + 8 * fq); QF[(lt * 4 + j) * 64 + lane] = ld2x8(Qb + (size_t)l * 1024 + 32 * j + 4 * fq); }
#pragma unroll
        for (int j2 = 0; j2 < 2; ++j2) { float pv[8];
#pragma unroll
            for (int hf = 0; hf < 2; ++hf) { f32x4 acc = zero4;
                if (32 * j2 <= 16 * lt + 15) {
#pragma unroll
                    for (int j = 0; j < 4; ++j) { const bf16x8 kf = *(const bf16x8*)(Qb + (size_t)(32 * j2 + 8 * (fr >> 2) + (fr & 3) + 4 * hf) * 1024 + 128 + 32 * j + 8 * fq); acc = MFMA16(kf, Qf[j], acc); } }
#pragma unroll
                for (int i = 0; i < 4; ++i) { const int sidx = 32 * j2 + 8 * fq + 4 * hf + i; pv[hf * 4 + i] = (sidx <= l) ? acc[i] * __expf(as_[j2][hf * 4 + i] - cml) : 0.f; } }
            PB[(lt * 2 + j2) * 64 + lane] = pack8(pv); }
    }
}

__device__ __forceinline__ void mlstm_unit(const KParams& P, int unit, int lane) {
    asm volatile("" : "+v"(lane));
    const int fr = lane & 15, fq = lane >> 4;
    const int bh = unit / 9, vs = unit % 9, b = bh >> 2, h = bh & 3;
    const bool den_unit = (vs == 8);
    const bf16_t* proj = (const bf16_t*)(P.ws + O_PROJ);
    const bf16_t* Qb = (const bf16_t*)((const char*)P.out + OUT_MQK) + (size_t)b * T * 1024 + h * 256;
    const bf16x8* KTF = (const bf16x8*)(P.ws + O_MKT) + (size_t)bh * 64 * 8 * 2 * 64;
    const bf16x8* VF = (const bf16x8*)(P.ws + O_MVT) + (size_t)bh * 64 * 8 * 2 * 64;
    const bf16x8* QFb = (const bf16x8*)(P.ws + O_XN) + (size_t)bh * 64 * 4 * 4 * 64;
    float* NUM = P.out;
    float* DEN = (float*)(P.ws + O_DEN) + (size_t)bh * T;
    const float bi = P.in[16][h], bfv = P.in[17][h];
    const f32x4 zero4 = {0.f, 0.f, 0.f, 0.f};
    f32x4 Ct[8];
#pragma unroll
    for (int i = 0; i < 8; ++i) Ct[i] = zero4;
    float m_prev = 0.f;
    __builtin_amdgcn_s_setprio(3);
    const float* GTb = (const float*)(P.ws + O_GT) + (size_t)bh * 64 * 192;
    float a_n = GTb[lane], bc_n = GTb[64 + lane], cm_n = GTb[128 + lane];
    const bf16x8* PBb = (const bf16x8*)(P.ws + O_PB) + (size_t)bh * 64 * 4 * 2 * 64;
#pragma unroll 1
    for (int c = 0; c < 64; ++c) {
        const int tc = c * 64;
        bf16x8 pbv[8], Qa[4][4];
#pragma unroll
        for (int i = 0; i < 8; ++i) pbv[i] = PBb[(size_t)(c * 8 + i) * 64 + lane];
#pragma unroll
        for (int lt = 0; lt < 4; ++lt)
#pragma unroll
            for (int j = 0; j < 4; ++j) Qa[lt][j] = QFb[(size_t)((c * 4 + lt) * 4 + j) * 64 + lane];
        const float a = a_n, bc = bc_n, cm = cm_n;
        { const int cn = (c < 63) ? c + 1 : c; const float* gp = GTb + (size_t)cn * 192; a_n = gp[lane]; bc_n = gp[64 + lane]; cm_n = gp[128 + lane]; }
        const float gg = __shfl(bc, 63);
        const float mw = gg + __shfl(cm, 63);
        const float m_new = fmaxf(gg + m_prev, mw);
        const float decay = __expf(gg + m_prev - m_new);
        const float wv = __expf(gg + a - m_new);
        const float mm = fmaxf(m_prev, cm);
        const float inter = __expf(m_prev - mm);
        const float eneg = __expf(-(bc + mm));
        bf16x8 Cb[4];
#pragma unroll
        for (int j = 0; j < 4; ++j) { float f[8];
#pragma unroll
            for (int i = 0; i < 4; ++i) { f[i] = Ct[2 * j][i]; f[4 + i] = Ct[2 * j + 1][i]; }
            Cb[j] = pack8(f); }
        bf16x8 Vf[2];
#pragma unroll
        for (int j2 = 0; j2 < 2; ++j2) {
            if (den_unit) { const unsigned o = (fr == 0) ? 0x3F803F80u : 0u; u32x4 w = {o, o, o, o}; Vf[j2] = __builtin_bit_cast(bf16x8, w); }
            else Vf[j2] = VF[(size_t)((c * 8 + vs) * 2 + j2) * 64 + lane];
        }
#define ML_BODY(lt_) { const int l = 16 * (lt_) + fr; \
            const float mml = __shfl(mm, l), il = __shfl(inter, l), en = __shfl(eneg, l); \
            const float fl = __expf(__shfl(cm, l) - mml); \
            f32x4 a1 = zero4, a2 = zero4; \
            _Pragma("unroll") for (int j = 0; j < 4; ++j) a1 = MFMA16(Cb[j], Qa[lt_][j], a1); \
            _Pragma("unroll") for (int j2 = 0; j2 < 2; ++j2) a2 = MFMA16(Vf[j2], pbv[(lt_) * 2 + j2], a2); \
            const f32x4 nv = a1 * il + a2 * fl; \
            if (!den_unit) *(f32x4*)(NUM + (size_t)(b * T + tc + l) * 512 + h * 128 + vs * 16 + 4 * fq) = nv; \
            else if (fq == 0) DEN[tc + l] = fmaxf(fabsf(nv[0]), en); }
        ML_BODY(0) ML_BODY(1)
        asm volatile("" ::: "memory");
        bf16x8 ktf[8][2];
#pragma unroll
        for (int kt = 0; kt < 8; ++kt)
#pragma unroll
            for (int j2 = 0; j2 < 2; ++j2) ktf[kt][j2] = KTF[(size_t)((c * 8 + kt) * 2 + j2) * 64 + lane];
        ML_BODY(2) ML_BODY(3)
#undef ML_BODY
        bf16x8 wV[2];
#pragma unroll
        for (int j2 = 0; j2 < 2; ++j2) { float f[8];
            if (den_unit) {
#pragma unroll
                for (int e = 0; e < 8; ++e) { const float w = __shfl(wv, 32 * j2 + 8 * fq + e); f[e] = (fr == 0) ? w : 0.f; }
            } else { unpack8(__builtin_bit_cast(u32x4, Vf[j2]), f);
#pragma unroll
                for (int e = 0; e < 8; ++e) f[e] *= __shfl(wv, 32 * j2 + 8 * fq + e); }
            wV[j2] = pack8(f); }
#pragma unroll
        for (int kt = 0; kt < 8; ++kt) { f32x4 acc = Ct[kt] * decay;
#pragma unroll
            for (int j2 = 0; j2 < 2; ++j2) acc = MFMA16(ktf[kt][j2], wV[j2], acc);
            Ct[kt] = acc; }
        m_prev = m_new;
    }
    __builtin_amdgcn_s_setprio(0);
}

template <int MODE>
__device__ __forceinline__ void nsa_branch(const bf16_t* Kb, const bf16_t* Vt, int ldv, int kb_lo, int kb_hi, const bf16x8 (&qf)[4][2], const float (&slope2)[4],
                                           int t, unsigned selLo, unsigned selHi, float (&l)[4], f32x4 (&o)[4][4], LAS float* impL, int fr, int fq) {
    const f32x4 zero4 = {0.f, 0.f, 0.f, 0.f};
    constexpr float MREF = 16.0f;
#pragma unroll 1
    for (int kb = kb_lo; kb < kb_hi; ++kb) {
        bool selb = true;
        if (MODE == 2) { const int n = kb >> 1; selb = (n < 32) ? (((selLo >> n) & 1u) != 0u) : (((selHi >> (n - 32)) & 1u) != 0u); if (__ballot(selb) == 0ull) continue; }
        bf16x8 kf[2][2];
#pragma unroll
        for (int tl = 0; tl < 2; ++tl) {
            const bf16x8* kp = (const bf16x8*)Kb + (size_t)((kb * 2 + tl) * 2) * 64 + fq * 16 + fr; kf[tl][0] = kp[0]; kf[tl][1] = kp[64]; }
        bf16x8 vf[4];
        if (MODE != 0) {
#pragma unroll
            for (int dt = 0; dt < 4; ++dt) {
                vf[dt] = ((const bf16x8*)Vt)[(size_t)(kb * 4 + dt) * 64 + fq * 16 + fr]; }
        }
        bool valid[2][4]; float dist[2][4];
#pragma unroll
        for (int tl = 0; tl < 2; ++tl)
#pragma unroll
            for (int i = 0; i < 4; ++i) { const int key = kb * 32 + fq * 8 + tl * 4 + i;
                if (MODE <= 1) { const int pos = key * 16 + 31; valid[tl][i] = pos <= t; dist[tl][i] = (float)(t - pos); }
                else if (MODE == 2) { valid[tl][i] = selb && (key <= t); dist[tl][i] = (float)(t - key); }
                else { valid[tl][i] = (key <= t) && (t - key < 512); dist[tl][i] = (float)(t - key); } }
        float imps[2][4];
#pragma unroll
        for (int tl = 0; tl < 2; ++tl)
#pragma unroll
            for (int i = 0; i < 4; ++i) imps[tl][i] = 0.f;
#pragma unroll
        for (int r = 0; r < 4; ++r) {
            float p[8]; float ps = 0.f;
#pragma unroll
            for (int tl = 0; tl < 2; ++tl) { f32x4 sv = MFMA16(kf[tl][0], qf[r][0], zero4); sv = MFMA16(kf[tl][1], qf[r][1], sv);
#pragma unroll
                for (int i = 0; i < 4; ++i) {
                    float pe = __builtin_amdgcn_exp2f((sv[i] - MREF) - slope2[r] * dist[tl][i]);
                    pe = valid[tl][i] ? pe : 0.f;
                    if (MODE == 1) { pe *= l[r]; imps[tl][i] += pe; } else ps += pe;
                    p[tl * 4 + i] = pe; } }
            if (MODE != 1) l[r] += ps;
            if (MODE != 0) { const bf16x8 pb = pack8(p);
#pragma unroll
                for (int dt = 0; dt < 4; ++dt) o[dt][r] = MFMA16(vf[dt], pb, o[dt][r]); }
        }
        if (MODE == 1) {
#pragma unroll
            for (int tl = 0; tl < 2; ++tl) { const int n = kb * 8 + fq * 2 + tl; impL[fr * 64 + n] += (imps[tl][0] + imps[tl][1]) + (imps[tl][2] + imps[tl][3]); }
            LDS_WAIT();
#pragma unroll
            for (int tl = 0; tl < 2; ++tl) { const int n = kb * 8 + fq * 2 + tl + 1; if (n < 64) impL[fr * 64 + n] += imps[tl][3]; LDS_WAIT(); }
        }
    }
}

__device__ __forceinline__ void nsa_item(const KParams& P, LAS float* impL, int item, int lane) {
    asm volatile("" : "+v"(lane));
    const int fr = lane & 15, fq = lane >> 4;
    const int bg = item & 15, tt = 255 - (item >> 4), b = bg >> 1, g = bg & 1, t0 = tt * 16, t = t0 + fr;
    const bf16_t* proj = (const bf16_t*)(P.ws + O_PROJ);
    const size_t rowq = (size_t)(b * T + t) * LDP;
    const f32x4 zero4 = {0.f, 0.f, 0.f, 0.f};
    const float* qg = P.in[3];
    bf16x8 qf[4][2]; float slope2[4];
#pragma unroll
    for (int r = 0; r < 4; ++r) {
        const int hd = g * 4 + r;
        const bf16_t* qp = proj + rowq + CQ + hd * 64 + fq * 8;
        float f0[8], f1[8]; unpack8(*(const u32x4*)qp, f0); unpack8(*(const u32x4*)(qp + 32), f1);
        float ss = 0.f;
#pragma unroll
        for (int e = 0; e < 8; ++e) ss += f0[e] * f0[e] + f1[e] * f1[e];
        ss += __shfl_xor(ss, 16); ss += __shfl_xor(ss, 32);
        const float rs = rsqrtf(ss * (1.0f / 64.0f) + EPS) * (0.125f * LOG2E);
#pragma unroll
        for (int e = 0; e < 8; ++e) { f0[e] *= rs * qg[fq * 8 + e]; f1[e] *= rs * qg[32 + fq * 8 + e]; }
        qf[r][0] = pack8(f0); qf[r][1] = pack8(f1);
        slope2[r] = __builtin_amdgcn_exp2f(-(float)(hd + 1)) * LOG2E;
    }
    u32x2 acc[4][4];
#pragma unroll
    for (int dt = 0; dt < 4; ++dt)
#pragma unroll
        for (int r = 0; r < 4; ++r) acc[dt][r] = (u32x2){0u, 0u};
    float l[4]; f32x4 o[4][4];
#pragma unroll
    for (int i = 0; i < 16; ++i) impL[i * 64 + lane] = 0.f;
    LDS_WAIT();
    if (t0 >= 16) {
        const bf16_t* KCp = (const bf16_t*)(P.ws + O_KC) + (size_t)bg * 256 * 64;
        const bf16_t* VCp = (const bf16_t*)(P.ws + O_VCT) + (size_t)bg * 64 * 256;
        const int kb_hi = (t0 / 16 + 31) / 32;
#pragma unroll
        for (int r = 0; r < 4; ++r) { l[r] = 0.f;
#pragma unroll
            for (int dt = 0; dt < 4; ++dt) o[dt][r] = zero4; }
        nsa_branch<0>(KCp, VCp, 256, 0, kb_hi, qf, slope2, t, 0u, 0u, l, o, impL, fr, fq);
#pragma unroll
        for (int r = 0; r < 4; ++r) { l[r] += __shfl_xor(l[r], 16); l[r] += __shfl_xor(l[r], 32); l[r] = (l[r] > 0.f) ? 1.0f / l[r] : 0.f; }
        nsa_branch<1>(KCp, VCp, 256, 0, kb_hi, qf, slope2, t, 0u, 0u, l, o, impL, fr, fq);
#pragma unroll
        for (int r = 0; r < 4; ++r) { const float gt = sigmoidf_(bf2f(proj[rowq + CG + (g * 4 + r) * 3 + 0]));
#pragma unroll
            for (int dt = 0; dt < 4; ++dt) { u32x2 w; w.x = cvt_pk(o[dt][r][0] * gt, o[dt][r][1] * gt); w.y = cvt_pk(o[dt][r][2] * gt, o[dt][r][3] * gt); acc[dt][r] = w; } }
    }
    LDS_WAIT();
    unsigned selLo = 0u, selHi = 0u;
#pragma unroll 1
    for (int tau = 0; tau < 16; ++tau) {
        const int tq = t0 + tau; float v = impL[tau * 64 + lane];
        if (lane == (tq >> 6) || lane == 0) v = 1e9f; else if (64 * lane > tq) v = -1e9f;
        int rank = 0;
#pragma unroll 8
        for (int mi = 0; mi < 64; ++mi) { const float vm = __uint_as_float(__builtin_amdgcn_readlane(__float_as_uint(v), mi)); rank += ((vm > v) || (vm == v && mi < lane)) ? 1 : 0; }
        const unsigned long long msk = __ballot(rank < 16);
        if (fr == tau) { selLo = (unsigned)msk; selHi = (unsigned)(msk >> 32); }
    }
    {
        const bf16_t* Ks = (const bf16_t*)(P.ws + O_KSN) + (size_t)bg * T * 64;
        const bf16_t* Vs = (const bf16_t*)(P.ws + O_VST) + (size_t)bg * 64 * T;
#pragma unroll
        for (int r = 0; r < 4; ++r) { l[r] = 0.f;
#pragma unroll
            for (int dt = 0; dt < 4; ++dt) o[dt][r] = zero4; }
        nsa_branch<2>(Ks, Vs, T, 0, (t0 / 64 + 1) * 2, qf, slope2, t, selLo, selHi, l, o, impL, fr, fq);
#pragma unroll
        for (int r = 0; r < 4; ++r) { l[r] += __shfl_xor(l[r], 16); l[r] += __shfl_xor(l[r], 32);
            const float gt = sigmoidf_(bf2f(proj[rowq + CG + (g * 4 + r) * 3 + 1])); const float sc = (l[r] > 0.f) ? gt / l[r] : 0.f;
#pragma unroll
            for (int dt = 0; dt < 4; ++dt) { const u32x2 w = acc[dt][r];
                const f32x4 ov = (f32x4){__uint_as_float(w.x << 16), __uint_as_float(w.x & 0xffff0000u), __uint_as_float(w.y << 16), __uint_as_float(w.y & 0xffff0000u)} + o[dt][r] * sc;
                u32x2 w2; w2.x = cvt_pk(ov[0], ov[1]); w2.y = cvt_pk(ov[2], ov[3]); acc[dt][r] = w2; } }
    }
    {
        const bf16_t* Kw = (const bf16_t*)(P.ws + O_KWN) + (size_t)bg * T * 64;
        const bf16_t* Vw = (const bf16_t*)(P.ws + O_VWT) + (size_t)bg * 64 * T;
#pragma unroll
        for (int r = 0; r < 4; ++r) { l[r] = 0.f;
#pragma unroll
            for (int dt = 0; dt < 4; ++dt) o[dt][r] = zero4; }
        const int kb_lo = (t0 > 511) ? (t0 - 511) / 32 : 0;
        nsa_branch<3>(Kw, Vw, T, kb_lo, t0 / 32 + 1, qf, slope2, t, 0u, 0u, l, o, impL, fr, fq);
        bf16_t* Yp = (bf16_t*)(P.ws + O_Y) + (size_t)(b * T + t) * DM + g * 256;
#pragma unroll
        for (int r = 0; r < 4; ++r) { l[r] += __shfl_xor(l[r], 16); l[r] += __shfl_xor(l[r], 32);
            const float gt = sigmoidf_(bf2f(proj[rowq + CG + (g * 4 + r) * 3 + 2])); const float sc = (l[r] > 0.f) ? gt / l[r] : 0.f;
#pragma unroll
            for (int dt = 0; dt < 4; ++dt) { const u32x2 w = acc[dt][r];
                const f32x4 ov = (f32x4){__uint_as_float(w.x << 16), __uint_as_float(w.x & 0xffff0000u), __uint_as_float(w.y << 16), __uint_as_float(w.y & 0xffff0000u)} + o[dt][r] * sc;
                u32x2 w2; w2.x = cvt_pk(ov[0], ov[1]); w2.y = cvt_pk(ov[2], ov[3]); *(u32x2*)(Yp + r * 64 + dt * 16 + fq * 4) = w2; } }
    }
}

#ifndef PH_MASK
#define PH_MASK 1023
#endif
__global__ void __launch_bounds__(512) fwd_kernel(KParams P) {
    extern __shared__ __attribute__((aligned(16))) unsigned char lds_raw[];
    LAS unsigned char* lds = (LAS unsigned char*)lds_raw;
    cg::grid_group grid = cg::this_grid();
    const int G = gridDim.x, bx = blockIdx.x, NGW = G * 8;
    unsigned char* ws = P.ws;
#define GRID_SYNC() do { __syncthreads(); grid.sync(); } while (0)
#define FRESH_IDS int tid = threadIdx.x; asm volatile("" : "+v"(tid)); const int lane = tid & 63, wave = __builtin_amdgcn_readfirstlane(tid >> 6), gw = bx * 8 + wave; LAS float* scr = (LAS float*)(lds + wave * 16384); (void)lane; (void)gw; (void)scr;
#define WTIN ((bf16_t*)(ws + O_WTIN))
#define WTOUT ((bf16_t*)(ws + O_WTOUT))
#define WTGU ((bf16_t*)(ws + O_WTGU))
#define WTDN ((bf16_t*)(ws + O_WTDN))
#define WTC1 ((bf16_t*)(ws + O_WTC1))
#define WTC2 ((bf16_t*)(ws + O_WTC2))
#define WTMQK ((bf16_t*)(ws + O_WTMQK))
#define POSP ((float*)(ws + O_POSP))
#define POSB ((float*)(ws + O_POSB))
#define SSQ ((float*)(ws + O_SSQ))
#define DEN ((float*)(ws + O_DEN))
#define KC ((bf16_t*)(ws + O_KC))
#define VCT ((bf16_t*)(ws + O_VCT))
#define HC ((bf16_t*)(ws + O_HC))
#define XN ((bf16_t*)(ws + O_XN))
#define PROJ ((bf16_t*)(ws + O_PROJ))
#define UC ((bf16_t*)(ws + O_UC))
#define KSN ((bf16_t*)(ws + O_KSN))
#define KWN ((bf16_t*)(ws + O_KWN))
#define VST ((bf16_t*)(ws + O_VST))
#define VWT ((bf16_t*)(ws + O_VWT))
#define MVT ((bf16_t*)(ws + O_MVT))
#define MKT ((bf16_t*)(ws + O_MKT))
#define YB ((bf16_t*)(ws + O_Y))
#define MQK ((bf16_t*)((char*)P.out + OUT_MQK))

#if (PH_MASK >> 0) & 1
    {
        FRESH_IDS
        constexpr int I_IN = 16 * 89, I_OUT = 16 * 32, I_G = 16 * 88, I_D = 44 * 32, I_C1 = 32 * 8, I_C2 = 4 * 2, I_MQ = 4 * 8;
        constexpr int NIT = I_IN + I_OUT + 2 * I_G + I_D + 2 * I_C1 + 2 * I_C2 + 2 * I_MQ;
        constexpr int NIT0 = I_IN + 2 * I_C1 + 2 * I_C2 + 2 * I_MQ;
        for (int it = gw; it < NIT0; it += NGW) {
            int r = it;
            if (r < I_IN) { transpose_item(P.in[2], INW, WTIN, DM, 0, 0, nullptr, 1.f, scr, r, lane); continue; } r -= I_IN;
            if (r < I_C1) { transpose_item(P.in[8], 256, WTC1, 2048, 0, 0, nullptr, 1.f, scr, r, lane); continue; } r -= I_C1;
            if (r < I_C1) { transpose_item(P.in[10], 256, WTC1 + 256 * 2048, 2048, 0, 0, nullptr, 1.f, scr, r, lane); continue; } r -= I_C1;
            if (r < I_C2) { transpose_item(P.in[9], 64, WTC2, 256, 0, 0, nullptr, 1.f, scr, r, lane); continue; } r -= I_C2;
            if (r < I_C2) { transpose_item(P.in[11], 64, WTC2 + 64 * 256, 256, 0, 0, nullptr, 1.f, scr, r, lane); continue; } r -= I_C2;
            if (r < I_MQ) { const int h = r >> 3; transpose_item(P.in[14] + h * 16384, 128, WTMQK, 128, h * 256, 0, nullptr, 1.f, scr, r & 7, lane); continue; } r -= I_MQ;
            { const int h = r >> 3; transpose_item(P.in[15] + h * 16384, 128, WTMQK, 128, h * 256 + 128, 0, nullptr, 0.08838834764831845f, scr, r & 7, lane); }
        }
        for (int i = bx * 512 + tid; i < (LDP - INW) * DM / 8; i += G * 512) ((u32x4*)(WTIN + (size_t)INW * DM))[i] = (u32x4){0u, 0u, 0u, 0u};
        const float* x = P.in[0]; const float* g1 = P.in[1];
        for (int mrow = gw; mrow < M; mrow += NGW) {
            const f32x4* xr = (const f32x4*)(x + (size_t)mrow * DM) + lane; f32x4 v[4]; float s = 0.f;
#pragma unroll
            for (int j = 0; j < 4; ++j) { v[j] = xr[64 * j]; s += (v[j][0] * v[j][0] + v[j][1] * v[j][1]) + (v[j][2] * v[j][2] + v[j][3] * v[j][3]); }
            const float rs = rsqrtf(wave_sum(s) * (1.0f / DM) + EPS);
            u32x2* o8 = (u32x2*)(XN + (size_t)mrow * DM) + lane;
#pragma unroll
            for (int j = 0; j < 4; ++j) { const f32x4 gv = ((const f32x4*)g1)[lane + 64 * j]; u32x2 w; w.x = cvt_pk(v[j][0] * rs * gv[0], v[j][1] * rs * gv[1]); w.y = cvt_pk(v[j][2] * rs * gv[2], v[j][3] * rs * gv[3]); o8[64 * j] = w; }
        }
        for (int kb = bx; kb < 64; kb += G) { const int kv = tid >> 8, n = tid & 255; const float* w1 = P.in[kv ? 10 : 8]; const float* pos = P.in[7]; float acc = 0.f;
#pragma unroll 8
            for (int kk = 32 * kb; kk < 32 * kb + 32; ++kk) acc += pos[kk] * w1[(size_t)kk * 256 + n];
            POSP[kb * 512 + tid] = acc; }
    }
#endif
    GRID_SYNC();
#if (PH_MASK >> 1) & 1
    {
        FRESH_IDS
        pg8::Cfg g{DM, DM, DM, 128, 128}; pg8::Sched2D S; S.init(XN, WTIN, (size_t)256 * DM * 2, (size_t)256 * DM * 2, M / 256, LDP / 256, G, bx);
        EpiBf16<0> E{PROJ, LDP, nullptr};
        pg8::gemm_phase(lds, g, S, E);
    }
#endif
    GRID_SYNC();
#if (PH_MASK >> 3) & 1
    {
        FRESH_IDS
        const int ncmp = (G >= 64) ? 32 : G, first = (G >= 64) ? 32 : 0;
        float* POSBp = (float*)(ws + O_SSQ) + (size_t)bx * 512;
        if (bx < ncmp) { float acc = 0.f; for (int kb = 0; kb < 64; ++kb) acc += POSP[kb * 512 + tid]; POSBp[tid] = acc; }
        if (bx >= first) {
            const float* cw = P.in[12]; const float* cb = P.in[13];
            SchedMqk S0{(const char*)UC, (const char*)WTMQK, first, G, bx}; pg8::Unit uu;
            for (int i = 0; S0.next(i, uu); ++i) {
                const int c4 = uu.pn * 128 + (tid & 31) * 4, rg = uu.pm * 256 + (tid >> 5) * 16;
                const f32x4 w0 = *(const f32x4*)(cw + c4), w1 = *(const f32x4*)(cw + 512 + c4), w2 = *(const f32x4*)(cw + 1024 + c4), w3 = *(const f32x4*)(cw + 1536 + c4), bb = *(const f32x4*)(cb + c4);
                const f32x4 z4 = {0.f, 0.f, 0.f, 0.f};
                f32x4 u3 = z4, u2 = z4, u1 = z4;
                if ((rg & (T - 1)) != 0) {
                    const u32x2 a3 = *(const u32x2*)(PROJ + (size_t)(rg - 3) * LDP + CU + c4), a2 = *(const u32x2*)(PROJ + (size_t)(rg - 2) * LDP + CU + c4), a1 = *(const u32x2*)(PROJ + (size_t)(rg - 1) * LDP + CU + c4);
                    u3 = (f32x4){__uint_as_float(a3.x << 16), __uint_as_float(a3.x & 0xffff0000u), __uint_as_float(a3.y << 16), __uint_as_float(a3.y & 0xffff0000u)};
                    u2 = (f32x4){__uint_as_float(a2.x << 16), __uint_as_float(a2.x & 0xffff0000u), __uint_as_float(a2.y << 16), __uint_as_float(a2.y & 0xffff0000u)};
                    u1 = (f32x4){__uint_as_float(a1.x << 16), __uint_as_float(a1.x & 0xffff0000u), __uint_as_float(a1.y << 16), __uint_as_float(a1.y & 0xffff0000u)}; }
#pragma unroll 4
                for (int r = 0; r < 16; ++r) { const u32x2 a0 = *(const u32x2*)(PROJ + (size_t)(rg + r) * LDP + CU + c4);
                    const f32x4 u0 = {__uint_as_float(a0.x << 16), __uint_as_float(a0.x & 0xffff0000u), __uint_as_float(a0.y << 16), __uint_as_float(a0.y & 0xffff0000u)};
                    const f32x4 yv = w0 * u3 + w1 * u2 + w2 * u1 + w3 * u0 + bb;
                    u32x2 o; o.x = cvt_pk(siluf_(yv[0]), siluf_(yv[1])); o.y = cvt_pk(siluf_(yv[2]), siluf_(yv[3])); *(u32x2*)(UC + (size_t)(rg + r) * 512 + c4) = o;
                    u3 = u2; u2 = u1; u1 = u0; }
            }
        }
        asm volatile("s_waitcnt vmcnt(0)" ::: "memory");
        __syncthreads();
        { pg8::Cfg g{2048, 16 * LDP, 2048, LDP * 2, 128}; SchedCmp S{(const char*)PROJ, (const char*)WTC1, ncmp, bx}; EpiBf16<1> E{HC, 256, POSBp}; pg8::gemm_phase(lds, g, S, E); }
        { pg8::Cfg g{128, 512, 128, 128, 128}; SchedMqk S{(const char*)UC, (const char*)WTMQK, first, G, bx}; EpiBf16<0> E{MQK, 1024, nullptr}; pg8::gemm_phase(lds, g, S, E); }
        if (bx >= first) {
            __syncthreads();
            const int gw2 = (bx - first) * 8 + wave, NGW2 = (G - first) * 8;
        for (int mrow = gw2; mrow < M; mrow += NGW2) {
            const int which = lane >> 4, c4 = (lane & 15) * 4, col = (which < 2 ? CKS : CKW) + (which & 1) * 64 + c4;
            const u32x2 w = *(const u32x2*)(PROJ + (size_t)mrow * LDP + col);
            float f[4] = {__uint_as_float(w.x << 16), __uint_as_float(w.x & 0xffff0000u), __uint_as_float(w.y << 16), __uint_as_float(w.y & 0xffff0000u)};
            float ss = (f[0] * f[0] + f[1] * f[1]) + (f[2] * f[2] + f[3] * f[3]);
            ss += __shfl_xor(ss, 1); ss += __shfl_xor(ss, 2); ss += __shfl_xor(ss, 4); ss += __shfl_xor(ss, 8);
            const float rs = rsqrtf(ss * (1.0f / 64.0f) + EPS); const float* gn = P.in[which < 2 ? 5 : 6] + c4;
            const int b = mrow / T, t = mrow % T;
            u32x2 ov; ov.x = cvt_pk(f[0] * rs * gn[0], f[1] * rs * gn[1]); ov.y = cvt_pk(f[2] * rs * gn[2], f[3] * rs * gn[3]);
            { const int kb = t >> 5, wi = t & 31, tl = (wi >> 2) & 1, frr = ((wi >> 3) << 2) | (wi & 3), ks = c4 >> 5, fqq = (c4 & 31) >> 3, e = c4 & 7;
              *(u32x2*)((which < 2 ? KSN : KWN) + (size_t)(b * 2 + (which & 1)) * T * 64 + ((size_t)(((kb * 2 + tl) * 2 + ks) * 64 + fqq * 16 + frr)) * 8 + e) = ov; }
        }
        for (int it = gw2; it < NB * 64 * 12; it += NGW2) {
            const int grp = it % 12, rest = it / 12, tti = rest & 63, b = rest >> 6;
            int col; bf16_t* dst;
            if (grp < 2) { col = CVS + grp * 64; dst = VST + (size_t)(b * 2 + grp) * 64 * T; }
            else if (grp < 4) { col = CVW + (grp - 2) * 64; dst = VWT + (size_t)(b * 2 + grp - 2) * 64 * T; }
            else { col = CVM + (grp - 4) * 64; dst = MVT + ((size_t)b * 512 + (grp - 4) * 64) * T; }
            if (grp < 4) tr64(PROJ + (size_t)(b * T + tti * 64) * LDP + col, LDP, dst, T, (LAS bf16_t*)scr, lane, 1, tti);
            else tr64(PROJ + (size_t)(b * T + tti * 64) * LDP + col, LDP, MVT + (size_t)(b * 4 + ((grp - 4) >> 1)) * 128 * T, T, (LAS bf16_t*)scr, lane, 2 | (((grp - 4) & 1) << 8), tti);
        }
        }
        asm volatile("s_waitcnt vmcnt(0)" ::: "memory");
        __syncthreads();
        {
        const f32x4 zero4 = {0.f, 0.f, 0.f, 0.f};
        const int fr = lane & 15, fq = lane >> 4;
        if (bx < ncmp) for (int L_ = bx; L_ < 32; L_ += ncmp) for (int rt_ = wave; rt_ < 16; rt_ += 8) { const int it = L_ * 16 + rt_;
            const int L = it >> 4, rt = it & 15, kv = L >> 4, bgi = (L & 7) * 2 + ((L >> 3) & 1);
            const bf16_t* Hp = HC + ((size_t)L * 256 + rt * 16 + fr) * 256 + fq * 8;
            const bf16_t* Wp = WTC2 + (size_t)kv * 64 * 256 + (size_t)fr * 256 + fq * 8;
            f32x4 acc[4] = {zero4, zero4, zero4, zero4};
#pragma unroll
            for (int ks = 0; ks < 8; ++ks) { const bf16x8 hf = *(const bf16x8*)(Hp + 32 * ks);
#pragma unroll
                for (int nt = 0; nt < 4; ++nt) { const bf16x8 wf = *(const bf16x8*)(Wp + (size_t)nt * 16 * 256 + 32 * ks);
                    acc[nt] = (kv == 0) ? MFMA16(wf, hf, acc[nt]) : MFMA16(hf, wf, acc[nt]); } }
            if (kv == 0) {
                float ss = 0.f;
#pragma unroll
                for (int nt = 0; nt < 4; ++nt) ss += (acc[nt][0] * acc[nt][0] + acc[nt][1] * acc[nt][1]) + (acc[nt][2] * acc[nt][2] + acc[nt][3] * acc[nt][3]);
                ss += __shfl_xor(ss, 16); ss += __shfl_xor(ss, 32);
                float rs = rsqrtf(ss * (1.0f / 64.0f) + EPS); const int j = rt * 16 + fr; if (j == 255) rs = 0.f;
                const float* gn = P.in[4];
#pragma unroll
                for (int nt = 0; nt < 4; ++nt) { const int n = 16 * nt + 4 * fq; u32x2 w; w.x = cvt_pk(acc[nt][0] * rs * gn[n], acc[nt][1] * rs * gn[n + 1]); w.y = cvt_pk(acc[nt][2] * rs * gn[n + 2], acc[nt][3] * rs * gn[n + 3]);
                    { const int kb = j >> 5, wi = j & 31, tl = (wi >> 2) & 1, frr = ((wi >> 3) << 2) | (wi & 3), ks = n >> 5, fqq = (n & 31) >> 3, e = n & 7;
                      *(u32x2*)(KC + (size_t)bgi * 256 * 64 + ((size_t)(((kb * 2 + tl) * 2 + ks) * 64 + fqq * 16 + frr)) * 8 + e) = w; } }
            } else {
#pragma unroll
                for (int nt = 0; nt < 4; ++nt) { const int j0 = rt * 16 + 4 * fq; const float v3 = (j0 + 3 == 255) ? 0.f : acc[nt][3];
                    u32x2 w; w.x = cvt_pk(acc[nt][0], acc[nt][1]); w.y = cvt_pk(acc[nt][2], v3);
                    { const int kb = j0 >> 5, fqq = (j0 & 31) >> 3, e = j0 & 7;
                      *(u32x2*)(VCT + (size_t)bgi * 64 * 256 + ((size_t)((kb * 4 + nt) * 64 + fqq * 16 + fr)) * 8 + e) = w; } }
            }
        }
        if (bx >= first) {
            SchedMqk S1{(const char*)UC, (const char*)WTMQK, first, G, bx}; pg8::Unit uu;
            for (int i = 0; S1.next(i, uu); ++i) {
                const int h = uu.pn, b = uu.pm >> 4, tti0 = (uu.pm & 15) * 4;
                { const int tti = tti0 + (wave >> 1), half = wave & 1;
                  tr64(MQK + (size_t)(b * T + tti * 64) * 1024 + h * 256 + 128 + half * 64, 1024, MKT + (size_t)(b * 4 + h) * 128 * T, T, (LAS bf16_t*)scr, lane, 2 | (half << 8), tti); }
#pragma unroll 1
                for (int j = 0; j < 4; ++j) if (((i * 4 + j) & 7) == wave) mlstm_ploc(P, (b * 4 + h) * 64 + tti0 + j, lane);
            }
        }
        }
    }
#endif
    GRID_SYNC();
#if (PH_MASK >> 5) & 1
    {
        FRESH_IDS
        unsigned* ctr = (unsigned*)(ws + O_CTL);
        for (;;) {
            unsigned it = 0; if (lane == 0) it = atomicAdd(ctr, 1u);
            it = __builtin_amdgcn_readfirstlane(it);
            if (it >= (unsigned)N_ML) break;
            mlstm_unit(P, (int)it, lane);
        }
        for (int dx = 0; dx < 8; ++dx) {
            const int x = (bx + dx) & 7; unsigned* q = ctr + 32 * (1 + x);
            for (;;) {
                unsigned it = 0; if (lane == 0) it = atomicAdd(q, 1u);
                it = __builtin_amdgcn_readfirstlane(it);
                if (it >= 512u) break;
                nsa_item(P, scr, (int)(((it & 255u) << 4) | (2u * x + (it >> 8))), lane);
            }
        }
        {
            constexpr int I_OUT = 16 * 32, I_G = 16 * 88, I_D = 44 * 32, NITF = I_OUT + 2 * I_G + I_D;
            unsigned* qf_ = ctr + 32 * 10;
            for (;;) {
                unsigned it = 0; if (lane == 0) it = atomicAdd(qf_, 1u);
                it = __builtin_amdgcn_readfirstlane(it);
                if (it >= (unsigned)NITF) break;
                int r = (int)it;
                if (r < I_OUT) { transpose_item(P.in[20], DM, WTOUT, DM, 0, 0, nullptr, 1.f, scr, r, lane); continue; } r -= I_OUT;
                if (r < I_G) { transpose_item(P.in[22], FF, WTGU, DM, 0, 1, P.in[21], 1.f, scr, r, lane); continue; } r -= I_G;
                if (r < I_G) { transpose_item(P.in[23], FF, WTGU, DM, 0, 2, P.in[21], 1.f, scr, r, lane); continue; } r -= I_G;
                transpose_item(P.in[24], DM, WTDN, FF, 0, 0, nullptr, 1.f, scr, r, lane);
            }
        }
    }
#endif
    GRID_SYNC();
#if (PH_MASK >> 6) & 1
    {
        FRESH_IDS
        const float* NUM = P.out; const float* ng = P.in[18]; const float* sk = P.in[19];
        for (int idx = gw * 4 + (lane >> 4); idx < M * 4; idx += NGW * 4) {
            const int mrow = idx >> 2, h = idx & 3, b = mrow / T, t = mrow % T, c = h * 128 + 8 * (lane & 15);
            const f32x4 n0 = *(const f32x4*)(NUM + (size_t)mrow * 512 + c), n1 = *(const f32x4*)(NUM + (size_t)mrow * 512 + c + 4);
            const float rd = 1.0f / DEN[(size_t)(b * 4 + h) * T + t];
            float og[8], uf[8]; unpack8(*(const u32x4*)(PROJ + (size_t)mrow * LDP + CO + c), og); unpack8(*(const u32x4*)(UC + (size_t)mrow * 512 + c), uf);
            float hv[8]; float ss = 0.f;
#pragma unroll
            for (int e = 0; e < 4; ++e) { hv[e] = n0[e] * rd * sigmoidf_(og[e]); hv[4 + e] = n1[e] * rd * sigmoidf_(og[4 + e]); }
#pragma unroll
            for (int e = 0; e < 8; ++e) ss += hv[e] * hv[e];
            ss += __shfl_xor(ss, 1); ss += __shfl_xor(ss, 2); ss += __shfl_xor(ss, 4); ss += __shfl_xor(ss, 8);
            const float rs = rsqrtf(ss * (1.0f / 128.0f) + EPS);
            const f32x4 g0 = *(const f32x4*)(ng + c), g1 = *(const f32x4*)(ng + c + 4), s0 = *(const f32x4*)(sk + c), s1 = *(const f32x4*)(sk + c + 4);
            float y[8];
#pragma unroll
            for (int e = 0; e < 4; ++e) { y[e] = hv[e] * rs * g0[e] + s0[e] * uf[e]; y[4 + e] = hv[4 + e] * rs * g1[e] + s1[e] * uf[4 + e]; }
            *(bf16x8*)(YB + (size_t)mrow * DM + 512 + c) = pack8(y);
        }
    }
#endif
    GRID_SYNC();
#if (PH_MASK >> 7) & 1
    {
        FRESH_IDS
        pg8::Cfg g{DM, DM, DM, 128, 128}; pg8::Sched2D S; S.init(YB, WTOUT, (size_t)256 * DM * 2, (size_t)256 * DM * 2, M / 256, DM / 256, G, bx);
        EpiOut E{P.in[0], P.out, XN, SSQ};
        pg8::gemm_phase(lds, g, S, E);
    }
#endif
    GRID_SYNC();
#if (PH_MASK >> 8) & 1
    {
        FRESH_IDS
        pg8::Cfg g{DM, DM, DM, 128, 128}; pg8::Sched2D S; S.init(XN, WTGU, (size_t)256 * DM * 2, (size_t)256 * DM * 2, M / 256, 2 * FF / 256, G, bx);
        EpiGU E{PROJ, SSQ};
        pg8::gemm_phase(lds, g, S, E);
    }
#endif
    GRID_SYNC();
#if (PH_MASK >> 9) & 1
    {
        FRESH_IDS
        pg8::Cfg g{FF, FF, FF, 128, 128}; pg8::Sched2D S; S.init(PROJ, WTDN, (size_t)256 * FF * 2, (size_t)256 * FF * 2, M / 256, DM / 256, G, bx);
        EpiDown E{P.out};
        pg8::gemm_phase(lds, g, S, E);
    }
#endif
}

extern "C" void kernel_launch(void* const* d_in, const int* in_sizes, int n_in, void* d_out, int out_size, void* d_ws, size_t ws_size, hipStream_t stream) {
    static int grid = 0;
    if (grid == 0) {
        if (n_in != 25 || out_size != M * DM || ws_size < O_END) { fprintf(stderr, "kernel_launch: unexpected shapes (n_in %d, out %d, ws %zu < %zu)\n", n_in, out_size, ws_size, (size_t)O_END); grid = -1; return; }
        int dev = 0, cus = 0, per_cu = 0;
        hipGetDevice(&dev); hipDeviceGetAttribute(&cus, hipDeviceAttributeMultiprocessorCount, dev);
        if (hipFuncSetAttribute((const void*)fwd_kernel, hipFuncAttributeMaxDynamicSharedMemorySize, LDS_BYTES) != hipSuccess) { fprintf(stderr, "kernel_launch: hipFuncSetAttribute failed\n"); grid = -1; return; }
        if (hipOccupancyMaxActiveBlocksPerMultiprocessor(&per_cu, (const void*)fwd_kernel, 512, LDS_BYTES) != hipSuccess || per_cu < 1) { fprintf(stderr, "kernel_launch: occupancy query gave %d\n", per_cu); (void)hipGetLastError(); grid = -1; return; }
        grid = cus;
    }
    if (grid < 0) return;
    (void)hipMemsetAsync((char*)d_ws + O_CTL, 0, 4096, stream);
    KParams p{};
    for (int i = 0; i < 25; ++i) p.in[i] = (const float*)d_in[i];
    p.out = (float*)d_out; p.ws = (unsigned char*)d_ws;
    void* args[] = {&p};
    hipError_t e = hipLaunchCooperativeKernel((const void*)fwd_kernel, dim3(grid), dim3(512), args, LDS_BYTES, stream);
    if (e != hipSuccess) fprintf(stderr, "cooperative launch failed: %s (grid %d)\n", hipGetErrorString(e), grid);
}
```

```cpp
#include <hip/hip_runtime.h>
#include <hip/hip_cooperative_groups.h>
#include <cstdio>
#include <cstdint>
namespace cg = cooperative_groups;

#define LAS __attribute__((address_space(3)))
typedef unsigned short bf16_t;
typedef short bf16x8 __attribute__((ext_vector_type(8)));
typedef float f32x4 __attribute__((ext_vector_type(4)));
typedef float f32x2 __attribute__((ext_vector_type(2)));
typedef unsigned u32x4 __attribute__((ext_vector_type(4)));
typedef unsigned u32x2 __attribute__((ext_vector_type(2)));

constexpr int NB = 8, T = 4096, DM = 1024, M = NB * T, LDP = 3072, FF = 2816;
constexpr int CQ = 0, CKC = 512, CVC = 640, CKS = 768, CVS = 896, CKW = 1024, CVW = 1152, CG = 1280, CU = 1304, CVM = 1816, CO = 2328, CI = 2840, CF = 2844, INW = 2848;
constexpr float EPS = 1e-6f, LOG2E = 1.4426950408889634f;

constexpr size_t al(size_t x) { return (x + 255) & ~(size_t)255; }
constexpr size_t O_CTL = 0;
constexpr size_t O_WTIN = 65536;
constexpr size_t O_WTOUT = O_WTIN + al((size_t)LDP * DM * 2);
constexpr size_t O_WTGU = O_WTOUT + al((size_t)DM * DM * 2);
constexpr size_t O_WTDN = O_WTGU + al((size_t)2 * FF * DM * 2);
constexpr size_t O_WTC1 = O_WTDN + al((size_t)DM * FF * 2);
constexpr size_t O_WTC2 = O_WTC1 + al((size_t)2 * 256 * 2048 * 2);
constexpr size_t O_WTMQK = O_WTC2 + al((size_t)2 * 64 * 256 * 2);
constexpr size_t O_POSP = O_WTMQK + al((size_t)4 * 256 * 128 * 2);
constexpr size_t O_POSB = O_POSP + al((size_t)64 * 512 * 4);
constexpr size_t O_SSQ = O_POSB + al((size_t)512 * 4);
constexpr size_t O_DEN = O_SSQ + al((size_t)M * 16 * 4);
constexpr size_t O_KC = O_DEN + al((size_t)32 * T * 4);
constexpr size_t O_VCT = O_KC + al((size_t)16 * 256 * 64 * 2);
constexpr size_t O_HC = O_VCT + al((size_t)16 * 64 * 256 * 2);
constexpr size_t O_XN = O_HC + al((size_t)32 * 256 * 256 * 2);
constexpr size_t O_PROJ = O_XN + al((size_t)M * DM * 2);
constexpr size_t O_UC = O_PROJ + al((size_t)(M + 64) * LDP * 2);
constexpr size_t O_KSN = O_UC + al((size_t)M * 512 * 2);
constexpr size_t O_KWN = O_KSN + al((size_t)16 * T * 64 * 2);
constexpr size_t O_VST = O_KWN + al((size_t)16 * T * 64 * 2);
constexpr size_t O_VWT = O_VST + al((size_t)16 * T * 64 * 2);
constexpr size_t O_MVT = O_VWT + al((size_t)16 * T * 64 * 2);
constexpr size_t O_MKT = O_MVT + al((size_t)32 * 128 * T * 2);
constexpr size_t O_Y = O_MKT + al((size_t)32 * 128 * T * 2);
constexpr size_t O_PB = O_Y + al((size_t)M * DM * 2);
constexpr size_t O_GT = O_PB + al((size_t)32 * 64 * 4 * 2 * 64 * 16);
constexpr size_t O_END = O_GT + al((size_t)32 * 64 * 3 * 64 * 4);
constexpr size_t OUT_MQK = (size_t)M * 512 * 4;

constexpr int LDS_BYTES = 131072 + 4096;
constexpr int N_ML = 288, N_NSA = 4096;

struct KParams { const float* in[25]; float* out; unsigned char* ws; };

__device__ __forceinline__ float bf2f(unsigned short h) { return __uint_as_float(((unsigned)h) << 16); }
__device__ __forceinline__ unsigned cvt_pk(float lo, float hi) { unsigned r; asm("v_cvt_pk_bf16_f32 %0, %1, %2" : "=v"(r) : "v"(lo), "v"(hi)); return r; }
__device__ __forceinline__ unsigned short f2bf(float f) { return (unsigned short)(cvt_pk(f, 0.f) & 0xffffu); }
__device__ __forceinline__ void unpack8(const u32x4 w, float* f) {
#pragma unroll
    for (int i = 0; i < 4; ++i) { f[2 * i] = __uint_as_float(w[i] << 16); f[2 * i + 1] = __uint_as_float(w[i] & 0xffff0000u); }
}
__device__ __forceinline__ bf16x8 pack8(const float* f) {
    u32x4 w; w.x = cvt_pk(f[0], f[1]); w.y = cvt_pk(f[2], f[3]); w.z = cvt_pk(f[4], f[5]); w.w = cvt_pk(f[6], f[7]);
    return __builtin_bit_cast(bf16x8, w);
}
__device__ __forceinline__ float sigmoidf_(float x) { return 1.0f / (1.0f + __expf(-x)); }
__device__ __forceinline__ float siluf_(float x) { return x * sigmoidf_(x); }
__device__ __forceinline__ float gelu_tanh(float x) { const float u = 0.7978845608028654f * (x + 0.044715f * x * x * x); const float e = __expf(2.0f * u); const float th = 1.0f - 2.0f / (e + 1.0f); return 0.5f * x * (1.0f + th); }
#define LDS_WAIT() asm volatile("s_waitcnt lgkmcnt(0)" ::: "memory")
#define MFMA16(a, b, c) __builtin_amdgcn_mfma_f32_16x16x32_bf16((a), (b), (c), 0, 0, 0)

namespace pg8 {
constexpr int BM = 256, BK = 64, HALF = 128, HTB = HALF * BK * 2, STAGE_BYTES = 8 * HTB;
__device__ __forceinline__ int lds_byte(int r, int c) { const int st = (r >> 4) * 2 + (c >> 5), rr = r & 15, cc = c & 31, ob = rr * 64 + cc * 2; return st * 1024 + (ob ^ (((ob >> 9) & 1) << 5)); }
__device__ __forceinline__ void stage_rc(int b, int& R, int& C) { const int st = b / 1024, sb = b % 1024, swz = sb ^ (((sb >> 9) & 1) << 5); R = (st >> 1) * 16 + swz / 64; C = (st & 1) * 32 + (swz % 64) / 2; }
__device__ __forceinline__ int perm32(int rho) { const int n = rho >> 4, i = rho & 15; return 8 * (i >> 2) + 4 * n + (i & 3); }
struct Unit { int pm, pn; const char* A; const char* B; };
struct Cfg { int K, lda, ldb, kstepA, kstepB; };

template <class Epi, class Sched>
__device__ __forceinline__ void gemm_phase(LAS unsigned char* lds, const Cfg g, const Sched& S, const Epi& E) {
    int tid = threadIdx.x; asm volatile("" : "+v"(tid)); const int wid = __builtin_amdgcn_readfirstlane(tid >> 6), lane = tid & 63, wr = wid >> 2, wc = wid & 3, fr = lane & 15, fq = lane >> 4;
    const int nt = g.K / BK;
    unsigned voffA[2], voffB[2];
#pragma unroll
    for (int i = 0; i < 2; ++i) { int R, C; stage_rc(tid * 16 + i * 8192, R, C); const int Rb = Epi::PERM ? ((R & ~31) + perm32(R & 31)) : R;
        voffA[i] = (unsigned)(R * g.lda + C) * 2u; voffB[i] = (unsigned)(Rb * g.ldb + C) * 2u; }
    const size_t kstepA = (size_t)g.kstepA, kstepB = (size_t)g.kstepB;
    const size_t hstepA = (size_t)HALF * g.lda * 2, hstepB = (size_t)HALF * g.ldb * 2;
    const unsigned ldsw = (unsigned)wid * 1024u;
    const int aoff = lds_byte(wr * 64 + fr, fq * 8), boff = lds_byte(wc * 32 + fr, fq * 8);
#define PG8_SA(b, h) (((b) * 2 + (h)) * HTB)
#define PG8_SB(b, h) ((4 + (b) * 2 + (h)) * HTB)
#define PG8_STAGE(bufoff, gbase, voff) do { _Pragma("unroll") for (int _i = 0; _i < 2; ++_i) \
        __builtin_amdgcn_global_load_lds((const unsigned*)((const char*)(gbase) + (voff)[_i]), (LAS unsigned*)(lds + (bufoff) + ldsw + _i * 8192), 16, 0, 0); } while (0)
#define PG8_LDA(dst, b, h) do { _Pragma("unroll") for (int m = 0; m < 4; ++m) _Pragma("unroll") for (int k = 0; k < 2; ++k) dst[m][k] = *(const LAS bf16x8*)(lds + PG8_SA(b, h) + aoff + m * 2048 + k * 1024); } while (0)
#define PG8_LDB(dst, b, h) do { _Pragma("unroll") for (int n = 0; n < 2; ++n) _Pragma("unroll") for (int k = 0; k < 2; ++k) dst[n][k] = *(const LAS bf16x8*)(lds + PG8_SB(b, h) + boff + n * 2048 + k * 1024); } while (0)
#define PG8_MMA(ai, bj, At, Bt) do { __builtin_amdgcn_s_setprio(1); _Pragma("unroll") for (int m = 0; m < 4; ++m) _Pragma("unroll") for (int n = 0; n < 2; ++n) _Pragma("unroll") for (int k = 0; k < 2; ++k) \
        acc[ai][bj][m][n] = __builtin_amdgcn_mfma_f32_16x16x32_bf16(Bt[n][k], At[m][k], acc[ai][bj][m][n], 0, 0, 0); __builtin_amdgcn_s_setprio(0); } while (0)
#define PG8_WAIT_V(n) asm volatile("s_waitcnt vmcnt(" #n ")" ::: "memory")
#define PG8_WAIT_L(n) asm volatile("s_waitcnt lgkmcnt(" #n ")" ::: "memory")
#define PG8_BAR __builtin_amdgcn_s_barrier()
#define PG8_SCHED __builtin_amdgcn_sched_barrier(0)
    Unit cur, nxt; int ui = 0;
    if (!S.next(0, cur)) return;
    f32x4 acc[2][2][4][2];
#pragma unroll
    for (int a = 0; a < 2; ++a)
#pragma unroll
        for (int b = 0; b < 2; ++b)
#pragma unroll
            for (int m = 0; m < 4; ++m)
#pragma unroll
                for (int n = 0; n < 2; ++n) acc[a][b][m][n] = (f32x4){0.f, 0.f, 0.f, 0.f};
    bf16x8 At[4][2], B0[2][2], B1[2][2];
    const char* cA = cur.A; const char* cB = cur.B;
    PG8_STAGE(PG8_SB(0, 0), cB, voffB); PG8_STAGE(PG8_SB(0, 1), cB + hstepB, voffB); PG8_STAGE(PG8_SA(0, 0), cA, voffA); PG8_STAGE(PG8_SA(0, 1), cA + hstepA, voffA);
    if (wr == 1) PG8_BAR;
    PG8_WAIT_V(2); PG8_BAR;
    PG8_STAGE(PG8_SB(1, 0), cB + kstepB, voffB); PG8_STAGE(PG8_SA(1, 0), cA + kstepA, voffA); PG8_STAGE(PG8_SB(1, 1), cB + hstepB + kstepB, voffB);
    PG8_WAIT_V(6); PG8_BAR;
    for (;;) {
        const bool has_next = S.next(ui + 1, nxt);
        const char* nA = has_next ? nxt.A : cA; const char* nB = has_next ? nxt.B : cB;
        for (int t = 0; t < nt; t += 2) {
            const bool last = (t == nt - 2);
            const char* a1 = cA + (size_t)(t + 1) * kstepA;
            const char* a2 = last ? nA : cA + (size_t)(t + 2) * kstepA; const char* b2 = last ? nB : cB + (size_t)(t + 2) * kstepB;
            const char* a3 = a2 + kstepA; const char* b3 = b2 + kstepB;
            PG8_LDB(B0, 0, 0); PG8_LDB(B1, 0, 1); PG8_SCHED; PG8_LDA(At, 0, 0); PG8_STAGE(PG8_SA(1, 1), a1 + hstepA, voffA);
            PG8_WAIT_V(8); PG8_WAIT_L(0); PG8_BAR; PG8_MMA(0, 0, At, B0); PG8_MMA(0, 1, At, B1); PG8_BAR; PG8_SCHED;
            PG8_LDA(At, 0, 1); PG8_STAGE(PG8_SB(0, 0), b2, voffB); PG8_STAGE(PG8_SB(0, 1), b2 + hstepB, voffB); PG8_STAGE(PG8_SA(0, 0), a2, voffA);
            PG8_WAIT_V(8); PG8_WAIT_L(0); PG8_BAR; PG8_MMA(1, 0, At, B0); PG8_MMA(1, 1, At, B1); PG8_BAR; PG8_SCHED;
            PG8_LDB(B0, 1, 0); PG8_LDB(B1, 1, 1); PG8_SCHED; PG8_LDA(At, 1, 0); PG8_STAGE(PG8_SA(0, 1), a2 + hstepA, voffA);
            PG8_WAIT_V(8); PG8_WAIT_L(0); PG8_BAR; PG8_MMA(0, 0, At, B0); PG8_MMA(0, 1, At, B1); PG8_BAR; PG8_SCHED;
            PG8_LDA(At, 1, 1); PG8_STAGE(PG8_SB(1, 0), b3, voffB); PG8_STAGE(PG8_SB(1, 1), b3 + hstepB, voffB); PG8_STAGE(PG8_SA(1, 0), a3, voffA);
            PG8_WAIT_V(8); PG8_WAIT_L(0); PG8_BAR; PG8_MMA(1, 0, At, B0); PG8_MMA(1, 1, At, B1); PG8_BAR; PG8_SCHED;
        }
        if (wr == 0) PG8_BAR;
        E(acc, cur, wr, wc, fr, fq);
        if (!has_next) break;
#pragma unroll
        for (int a = 0; a < 2; ++a)
#pragma unroll
            for (int b = 0; b < 2; ++b)
#pragma unroll
                for (int m = 0; m < 4; ++m)
#pragma unroll
                    for (int n = 0; n < 2; ++n) acc[a][b][m][n] = (f32x4){0.f, 0.f, 0.f, 0.f};
        cur = nxt; cA = nA; cB = nB; ++ui;
        if (wr == 1) PG8_BAR;
    }
    PG8_WAIT_V(0);
    PG8_BAR;
#undef PG8_SA
#undef PG8_SB
#undef PG8_STAGE
#undef PG8_LDA
#undef PG8_LDB
#undef PG8_MMA
#undef PG8_WAIT_V
#undef PG8_WAIT_L
#undef PG8_BAR
#undef PG8_SCHED
}

struct Sched2D {
    const char* A; const char* B; size_t tA, tB; int nM, nN, nwg, G, c;
    __device__ void init(const void* A_, const void* B_, size_t tA_, size_t tB_, int nM_, int nN_, int G_, int c_) { A = (const char*)A_; B = (const char*)B_; tA = tA_; tB = tB_; nM = nM_; nN = nN_; nwg = nM * nN; G = G_; c = c_; }
    __device__ bool next(int i, Unit& u) const {
        const long L = (long)i * G + c; if (L >= nwg) return false;
        int wgid = (int)L; { const int q = nwg / 8, r = nwg % 8, xcd = wgid % 8, off = wgid / 8; wgid = (xcd < r ? xcd * (q + 1) : r * (q + 1) + (xcd - r) * q) + off; }
        const int nig = 8 * nN, gid = wgid / nig, fm = gid * 8, gsz = (nM - fm) < 8 ? (nM - fm) : 8;
        u.pm = fm + ((wgid % nig) % gsz); u.pn = (wgid % nig) / gsz; u.A = A + (size_t)u.pm * tA; u.B = B + (size_t)u.pn * tB; return true;
    }
};
}

template <int ACT> struct EpiBf16 {
    static constexpr bool PERM = true;
    bf16_t* O; int ldc; const float* bias;
    __device__ __forceinline__ void operator()(const f32x4 (&acc)[2][2][4][2], const pg8::Unit& u, int wr, int wc, int fr, int fq) const {
        const int row0 = u.pm * 256 + wr * 64 + fr, col0 = u.pn * 256 + wc * 32 + 8 * fq;
#pragma unroll
        for (int ai = 0; ai < 2; ++ai)
#pragma unroll
            for (int m = 0; m < 4; ++m) { bf16_t* rowp = O + (size_t)(row0 + ai * 128 + m * 16) * ldc + col0;
#pragma unroll
                for (int bj = 0; bj < 2; ++bj) { f32x4 v0 = acc[ai][bj][m][0], v1 = acc[ai][bj][m][1];
                    if (ACT == 1) { const float* bp = bias + (u.pm >> 4) * 256 + wc * 32 + 8 * fq + bj * 128;
#pragma unroll
                        for (int e = 0; e < 4; ++e) { v0[e] = gelu_tanh(v0[e] + bp[e]); v1[e] = gelu_tanh(v1[e] + bp[4 + e]); } }
                    u32x4 w; w.x = cvt_pk(v0[0], v0[1]); w.y = cvt_pk(v0[2], v0[3]); w.z = cvt_pk(v1[0], v1[1]); w.w = cvt_pk(v1[2], v1[3]);
                    *(u32x4*)(rowp + bj * 128) = w; } }
    }
};
struct EpiOut {
    static constexpr bool PERM = false;
    const float* X; float* O; bf16_t* XB; float* SSQ;
    __device__ __forceinline__ void operator()(const f32x4 (&acc)[2][2][4][2], const pg8::Unit& u, int wr, int wc, int fr, int fq) const {
        const int col0 = u.pn * 256 + wc * 32 + 4 * fq;
#pragma unroll
        for (int ai = 0; ai < 2; ++ai)
#pragma unroll
            for (int m = 0; m < 4; ++m) { const int row = u.pm * 256 + ai * 128 + wr * 64 + m * 16 + fr; const size_t off = (size_t)row * DM + col0; float ss = 0.f;
#pragma unroll
                for (int bj = 0; bj < 2; ++bj)
#pragma unroll
                    for (int n = 0; n < 2; ++n) { const f32x4 xv = *(const f32x4*)(X + off + bj * 128 + n * 16); const f32x4 v = xv + acc[ai][bj][m][n];
                        *(f32x4*)(O + off + bj * 128 + n * 16) = v; u32x2 w; w.x = cvt_pk(v[0], v[1]); w.y = cvt_pk(v[2], v[3]); *(u32x2*)(XB + off + bj * 128 + n * 16) = w;
                        ss += (v[0] * v[0] + v[1] * v[1]) + (v[2] * v[2] + v[3] * v[3]); }
                ss += __shfl_xor(ss, 16); ss += __shfl_xor(ss, 32);
                if (fq == 0) SSQ[(size_t)row * 16 + u.pn * 4 + wc] = ss; }
    }
};
struct EpiGU {
    static constexpr bool PERM = true;
    bf16_t* H; const float* SSQ;
    __device__ __forceinline__ void operator()(const f32x4 (&acc)[2][2][4][2], const pg8::Unit& u, int wr, int wc, int fr, int fq) const {
        const int hc0 = u.pn * 128 + wc * 16 + 4 * fq;
#pragma unroll
        for (int ai = 0; ai < 2; ++ai)
#pragma unroll
            for (int m = 0; m < 4; ++m) { const int row = u.pm * 256 + ai * 128 + wr * 64 + m * 16 + fr;
                const f32x4* sp = (const f32x4*)(SSQ + (size_t)row * 16); const f32x4 s0 = sp[0], s1 = sp[1], s2 = sp[2], s3 = sp[3];
                const float ss = ((s0[0] + s0[1]) + (s0[2] + s0[3])) + ((s1[0] + s1[1]) + (s1[2] + s1[3])) + ((s2[0] + s2[1]) + (s2[2] + s2[3])) + ((s3[0] + s3[1]) + (s3[2] + s3[3]));
                const float rs = rsqrtf(ss * (1.0f / DM) + EPS);
#pragma unroll
                for (int bj = 0; bj < 2; ++bj) { const f32x4 gv = acc[ai][bj][m][0] * rs, uv = acc[ai][bj][m][1] * rs; float h[4];
#pragma unroll
                    for (int e = 0; e < 4; ++e) h[e] = siluf_(gv[e]) * uv[e];
                    u32x2 w; w.x = cvt_pk(h[0], h[1]); w.y = cvt_pk(h[2], h[3]); *(u32x2*)(H + (size_t)row * FF + hc0 + bj * 64) = w; } }
    }
};
struct EpiDown {
    static constexpr bool PERM = false;
    float* O;
    __device__ __forceinline__ void operator()(const f32x4 (&acc)[2][2][4][2], const pg8::Unit& u, int wr, int wc, int fr, int fq) const {
        const int col0 = u.pn * 256 + wc * 32 + 4 * fq;
#pragma unroll
        for (int ai = 0; ai < 2; ++ai)
#pragma unroll
            for (int m = 0; m < 4; ++m) { const int row = u.pm * 256 + ai * 128 + wr * 64 + m * 16 + fr; const size_t off = (size_t)row * DM + col0;
#pragma unroll
                for (int bj = 0; bj < 2; ++bj)
#pragma unroll
                    for (int n = 0; n < 2; ++n) { float* p = O + off + bj * 128 + n * 16; const f32x4 xv = *(const f32x4*)p; *(f32x4*)p = xv + acc[ai][bj][m][n]; } }
    }
};
struct SchedCmp {
    const char* proj; const char* wt; int ncu, c;
    __device__ bool next(int i, pg8::Unit& u) const { if (c >= ncu) return false; const int L = i * ncu + c; if (L >= 32) return false;
        const int kv = L >> 4, g = (L >> 3) & 1, b = L & 7; u.pm = L; u.pn = 0;
        u.A = proj + ((size_t)b * T * LDP + (kv ? CVC : CKC) + g * 64) * 2; u.B = wt + (size_t)kv * 256 * 2048 * 2; return true; }
};
struct SchedMqk {
    const char* uc; const char* wt; int first, G, c;
    __device__ bool next(int i, pg8::Unit& u) const { if (c < first) return false; const int L = i * (G - first) + (c - first); if (L >= 512) return false;
        const int h = L >> 7, pm = L & 127; u.pm = pm; u.pn = h; u.A = uc + ((size_t)pm * 256 * 512 + h * 128) * 2; u.B = wt + (size_t)h * 256 * 128 * 2; return true; }
};

__device__ __forceinline__ void transpose_item(const float* W, int N, bf16_t* WT, int ldt, int row_off, int mode, const float* ks, float mul, LAS float* scr, int item, int lane) {
    const int nblk = N / 32, kb = item / nblk, nb = item % nblk, k0 = 64 * kb, n0 = 32 * nb;
#pragma unroll 8
    for (int i = 0; i < 32; ++i) { const int kk = 2 * i + (lane >> 5); float v = W[(size_t)(k0 + kk) * N + n0 + (lane & 31)] * mul; if (ks) v *= ks[k0 + kk]; scr[kk * 33 + (lane & 31)] = v; }
    LDS_WAIT();
    const int c = lane & 7;
#pragma unroll
    for (int j = 0; j < 4; ++j) { const int n = n0 + (lane >> 3) + 8 * j; const LAS float* s = scr + (8 * c) * 33 + (n - n0);
        u32x4 o; o.x = cvt_pk(s[0 * 33], s[1 * 33]); o.y = cvt_pk(s[2 * 33], s[3 * 33]); o.z = cvt_pk(s[4 * 33], s[5 * 33]); o.w = cvt_pk(s[6 * 33], s[7 * 33]);
        const int dst = mode == 0 ? row_off + n : ((n >> 2) * 8 + (n & 3) + (mode == 2 ? 4 : 0));
        *(u32x4*)(WT + (size_t)dst * ldt + k0 + 8 * c) = o; }
    LDS_WAIT();
}
__device__ __forceinline__ void tr64(const bf16_t* src, size_t lds_, bf16_t* dst, size_t ldd, LAS bf16_t* L, int lane, int fragmajor = 0, int tti = 0) {
#pragma unroll
    for (int i = 0; i < 8; ++i) { const int row = i * 8 + (lane >> 3), ch = lane & 7; const u32x4 w = *(const u32x4*)(src + (size_t)row * lds_ + 8 * ch);
#pragma unroll
        for (int e = 0; e < 4; ++e) { L[(8 * ch + 2 * e) * 72 + row] = (bf16_t)(w[e] & 0xffffu); L[(8 * ch + 2 * e + 1) * 72 + row] = (bf16_t)(w[e] >> 16); } }
    LDS_WAIT();
#pragma unroll
    for (int i = 0; i < 8; ++i) { const int c = i * 8 + (lane >> 3), ch = lane & 7; const u32x4 w = *(const LAS u32x4*)(L + c * 72 + 8 * ch);
        if (!fragmajor) *(u32x4*)(dst + (size_t)c * ldd + 8 * ch) = w;
        else if (fragmajor == 1) *(u32x4*)(dst + ((size_t)(((tti * 2 + (ch >> 2)) * 4 + (c >> 4)) * 64 + (ch & 3) * 16 + (c & 15))) * 8) = w;
        else *(u32x4*)(dst + ((size_t)((((tti * 8 + (fragmajor >> 8) * 4 + (c >> 4)) * 2 + (ch >> 2)) * 64) + (ch & 3) * 16 + (c & 15))) * 8) = w; }
    LDS_WAIT();
}
__device__ __forceinline__ float wave_sum(float v) {
#pragma unroll
    for (int o = 1; o < 64; o <<= 1) v += __shfl_xor(v, o);
    return v;
}

__device__ __forceinline__ float scan_sum(float v, int lane) {
#pragma unroll
    for (int d = 1; d < 64; d <<= 1) { const float t = __shfl_up(v, d); if (lane >= d) v += t; }
    return v;
}
__device__ __forceinline__ float scan_max(float v, int lane) {
#pragma unroll
    for (int d = 1; d < 64; d <<= 1) { const float t = __shfl_up(v, d); if (lane >= d) v = fmaxf(v, t); }
    return v;
}
__device__ __forceinline__ bf16x8 ld2x8(const bf16_t* p) {
    const u32x2 lo = *(const u32x2*)p, hi = *(const u32x2*)(p + 16); u32x4 w; w.x = lo.x; w.y = lo.y; w.z = hi.x; w.w = hi.y; return __builtin_bit_cast(bf16x8, w);
}

__device__ __forceinline__ void mlstm_ploc(const KParams& P, int it, int lane) {
    asm volatile("" : "+v"(lane));
    const int fr = lane & 15, fq = lane >> 4;
    const int bh = it >> 6, c = it & 63, b = bh >> 2, h = bh & 3, tc = c * 64;
    const bf16_t* proj = (const bf16_t*)(P.ws + O_PROJ);
    const size_t grow = (size_t)(b * T + tc + lane) * LDP;
    const float li = bf2f(proj[grow + CI + h]) + P.in[16][h];
    const float fz = bf2f(proj[grow + CF + h]) + P.in[17][h];
    const float lf = fminf(fz, 0.f) - log1pf(__expf(-fabsf(fz)));
    const float bc = scan_sum(lf, lane), a = li - bc, cm = scan_max(a, lane);
    { float* GT = (float*)(P.ws + O_GT) + (size_t)it * 192; GT[lane] = a; GT[64 + lane] = bc; GT[128 + lane] = cm; }
    const bf16_t* Qb = (const bf16_t*)((const char*)P.out + OUT_MQK) + (size_t)(b * T + tc) * 1024 + h * 256;
    bf16x8* PB = (bf16x8*)(P.ws + O_PB) + (size_t)it * 4 * 2 * 64;
    bf16x8* QF = (bf16x8*)(P.ws + O_XN) + (size_t)it * 4 * 4 * 64;
    const f32x4 zero4 = {0.f, 0.f, 0.f, 0.f};
    float as_[2][8];
#pragma unroll
    for (int j2 = 0; j2 < 2; ++j2)
#pragma unroll
        for (int e = 0; e < 8; ++e) as_[j2][e] = __shfl(a, 32 * j2 + 8 * fq + e);
#pragma unroll 1
    for (int lt = 0; lt < 4; ++lt) {
        const int l = 16 * lt + fr; const float cml = __shfl(cm, l);
        bf16x8 Qf[4];
#pragma unroll
        for (int j = 0; j < 4; ++j) { Qf[j] = *(const bf16x8*)(Qb + (size_t)l * 1024 + 32 * j + 8 * fq); QF[(lt * 4 + j) * 64 + lane] = ld2x8(Qb + (size_t)l * 1024 + 32 * j + 4 * fq); }
#pragma unroll
        for (int j2 = 0; j2 < 2; ++j2) { float pv[8];
#pragma unroll
            for (int hf = 0; hf < 2; ++hf) { f32x4 acc = zero4;
                if (32 * j2 <= 16 * lt + 15) {
#pragma unroll
                    for (int j = 0; j < 4; ++j) { const bf16x8 kf = *(const bf16x8*)(Qb + (size_t)(32 * j2 + 8 * (fr >> 2) + (fr & 3) + 4 * hf) * 1024 + 128 + 32 * j + 8 * fq); acc = MFMA16(kf, Qf[j], acc); } }
#pragma unroll
                for (int i = 0; i < 4; ++i) { const int sidx = 32 * j2 + 8 * fq + 4 * hf + i; pv[hf * 4 + i] = (sidx <= l) ? acc[i] * __expf(as_[j2][hf * 4 + i] - cml) : 0.f; } }
            PB[(lt * 2 + j2) * 64 + lane] = pack8(pv); }
    }
}

__device__ __forceinline__ void mlstm_unit(const KParams& P, int unit, int lane) {
    asm volatile("" : "+v"(lane));
    const int fr = lane & 15, fq = lane >> 4;
    const int bh = unit / 9, vs = unit % 9, b = bh >> 2, h = bh & 3;
    const bool den_unit = (vs == 8);
    const bf16_t* proj = (const bf16_t*)(P.ws + O_PROJ);
    const bf16_t* Qb = (const bf16_t*)((const char*)P.out + OUT_MQK) + (size_t)b * T * 1024 + h * 256;
    const bf16x8* KTF = (const bf16x8*)(P.ws + O_MKT) + (size_t)bh * 64 * 8 * 2 * 64;
    const bf16x8* VF = (const bf16x8*)(P.ws + O_MVT) + (size_t)bh * 64 * 8 * 2 * 64;
    const bf16x8* QFb = (const bf16x8*)(P.ws + O_XN) + (size_t)bh * 64 * 4 * 4 * 64;
    float* NUM = P.out;
    float* DEN = (float*)(P.ws + O_DEN) + (size_t)bh * T;
    const float bi = P.in[16][h], bfv = P.in[17][h];
    const f32x4 zero4 = {0.f, 0.f, 0.f, 0.f};
    f32x4 Ct[8];
#pragma unroll
    for (int i = 0; i < 8; ++i) Ct[i] = zero4;
    float m_prev = 0.f;
    __builtin_amdgcn_s_setprio(3);
    const float* GTb = (const float*)(P.ws + O_GT) + (size_t)bh * 64 * 192;
    float a_n = GTb[lane], bc_n = GTb[64 + lane], cm_n = GTb[128 + lane];
    const bf16x8* PBb = (const bf16x8*)(P.ws + O_PB) + (size_t)bh * 64 * 4 * 2 * 64;
#pragma unroll 1
    for (int c = 0; c < 64; ++c) {
        const int tc = c * 64;
        bf16x8 pbv[8], Qa[4][4];
#pragma unroll
        for (int i = 0; i < 8; ++i) pbv[i] = PBb[(size_t)(c * 8 + i) * 64 + lane];
#pragma unroll
        for (int lt = 0; lt < 4; ++lt)
#pragma unroll
            for (int j = 0; j < 4; ++j) Qa[lt][j] = QFb[(size_t)((c * 4 + lt) * 4 + j) * 64 + lane];
        const float a = a_n, bc = bc_n, cm = cm_n;
        { const int cn = (c < 63) ? c + 1 : c; const float* gp = GTb + (size_t)cn * 192; a_n = gp[lane]; bc_n = gp[64 + lane]; cm_n = gp[128 + lane]; }
        const float gg = __shfl(bc, 63);
        const float mw = gg + __shfl(cm, 63);
        const float m_new = fmaxf(gg + m_prev, mw);
        const float decay = __expf(gg + m_prev - m_new);
        const float wv = __expf(gg + a - m_new);
        const float mm = fmaxf(m_prev, cm);
        const float inter = __expf(m_prev - mm);
        const float eneg = __expf(-(bc + mm));
        bf16x8 Cb[4];
#pragma unroll
        for (int j = 0; j < 4; ++j) { float f[8];
#pragma unroll
            for (int i = 0; i < 4; ++i) { f[i] = Ct[2 * j][i]; f[4 + i] = Ct[2 * j + 1][i]; }
            Cb[j] = pack8(f); }
        bf16x8 Vf[2];
#pragma unroll
        for (int j2 = 0; j2 < 2; ++j2) {
            if (den_unit) { const unsigned o = (fr == 0) ? 0x3F803F80u : 0u; u32x4 w = {o, o, o, o}; Vf[j2] = __builtin_bit_cast(bf16x8, w); }
            else Vf[j2] = VF[(size_t)((c * 8 + vs) * 2 + j2) * 64 + lane];
        }
#define ML_BODY(lt_) { const int l = 16 * (lt_) + fr; \
            const float mml = __shfl(mm, l), il = __shfl(inter, l), en = __shfl(eneg, l); \
            const float fl = __expf(__shfl(cm, l) - mml); \
            f32x4 a1 = zero4, a2 = zero4; \
            _Pragma("unroll") for (int j = 0; j < 4; ++j) a1 = MFMA16(Cb[j], Qa[lt_][j], a1); \
            _Pragma("unroll") for (int j2 = 0; j2 < 2; ++j2) a2 = MFMA16(Vf[j2], pbv[(lt_) * 2 + j2], a2); \
            const f32x4 nv = a1 * il + a2 * fl; \
            if (!den_unit) *(f32x4*)(NUM + (size_t)(b * T + tc + l) * 512 + h * 128 + vs * 16 + 4 * fq) = nv; \
            else if (fq == 0) DEN[tc + l] = fmaxf(fabsf(nv[0]), en); }
        ML_BODY(0) ML_BODY(1)
        asm volatile("" ::: "memory");
        bf16x8 ktf[8][2];
#pragma unroll
        for (int kt = 0; kt < 8; ++kt)
#pragma unroll
            for (int j2 = 0; j2 < 2; ++j2) ktf[kt][j2] = KTF[(size_t)((c * 8 + kt) * 2 + j2) * 64 + lane];
        ML_BODY(2) ML_BODY(3)
#undef ML_BODY
        bf16x8 wV[2];
#pragma unroll
        for (int j2 = 0; j2 < 2; ++j2) { float f[8];
            if (den_unit) {
#pragma unroll
                for (int e = 0; e < 8; ++e) { const float w = __shfl(wv, 32 * j2 + 8 * fq + e); f[e] = (fr == 0) ? w : 0.f; }
            } else { unpack8(__builtin_bit_cast(u32x4, Vf[j2]), f);
#pragma unroll
                for (int e = 0; e < 8; ++e) f[e] *= __shfl(wv, 32 * j2 + 8 * fq + e); }
            wV[j2] = pack8(f); }
#pragma unroll
        for (int kt = 0; kt < 8; ++kt) { f32x4 acc = Ct[kt] * decay;
#pragma unroll
            for (int j2 = 0; j2 < 2; ++j2) acc = MFMA16(ktf[kt][j2], wV[j2], acc);
            Ct[kt] = acc; }
        m_prev = m_new;
    }
    __builtin_amdgcn_s_setprio(0);
}

template <int MODE>
__device__ __forceinline__ void nsa_branch(const bf16_t* Kb, const bf16_t* Vt, int ldv, int kb_lo, int kb_hi, const bf16x8 (&qf)[4][2], const float (&slope2)[4],
                                           int t, unsigned selLo, unsigned selHi, float (&l)[4], f32x4 (&o)[4][4], LAS float* impL, int fr, int fq) {
    const f32x4 zero4 = {0.f, 0.f, 0.f, 0.f};
    constexpr float MREF = 16.0f;
#pragma unroll 1
    for (int kb = kb_lo; kb < kb_hi; ++kb) {
        bool selb = true;
        if (MODE == 2) { const int n = kb >> 1; selb = (n < 32) ? (((selLo >> n) & 1u) != 0u) : (((selHi >> (n - 32)) & 1u) != 0u); if (__ballot(selb) == 0ull) continue; }
        bf16x8 kf[2][2];
#pragma unroll
        for (int tl = 0; tl < 2; ++tl) {
            const bf16x8* kp = (const bf16x8*)Kb + (size_t)((kb * 2 + tl) * 2) * 64 + fq * 16 + fr; kf[tl][0] = kp[0]; kf[tl][1] = kp[64]; }
        bf16x8 vf[4];
        if (MODE != 0) {
#pragma unroll
            for (int dt = 0; dt < 4; ++dt) {
                vf[dt] = ((const bf16x8*)Vt)[(size_t)(kb * 4 + dt) * 64 + fq * 16 + fr]; }
        }
        bool valid[2][4]; float dist[2][4];
#pragma unroll
        for (int tl = 0; tl < 2; ++tl)
#pragma unroll
            for (int i = 0; i < 4; ++i) { const int key = kb * 32 + fq * 8 + tl * 4 + i;
                if (MODE <= 1) { const int pos = key * 16 + 31; valid[tl][i] = pos <= t; dist[tl][i] = (float)(t - pos); }
                else if (MODE == 2) { valid[tl][i] = selb && (key <= t); dist[tl][i] = (float)(t - key); }
                else { valid[tl][i] = (key <= t) && (t - key < 512); dist[tl][i] = (float)(t - key); } }
        float imps[2][4];
#pragma unroll
        for (int tl = 0; tl < 2; ++tl)
#pragma unroll
            for (int i = 0; i < 4; ++i) imps[tl][i] = 0.f;
#pragma unroll
        for (int r = 0; r < 4; ++r) {
            float p[8]; float ps = 0.f;
#pragma unroll
            for (int tl = 0; tl < 2; ++tl) { f32x4 sv = MFMA16(kf[tl][0], qf[r][0], zero4); sv = MFMA16(kf[tl][1], qf[r][1], sv);
#pragma unroll
                for (int i = 0; i < 4; ++i) {
                    float pe = __builtin_amdgcn_exp2f((sv[i] - MREF) - slope2[r] * dist[tl][i]);
                    pe = valid[tl][i] ? pe : 0.f;
                    if (MODE == 1) { pe *= l[r]; imps[tl][i] += pe; } else ps += pe;
                    p[tl * 4 + i] = pe; } }
            if (MODE != 1) l[r] += ps;
            if (MODE != 0) { const bf16x8 pb = pack8(p);
#pragma unroll
                for (int dt = 0; dt < 4; ++dt) o[dt][r] = MFMA16(vf[dt], pb, o[dt][r]); }
        }
        if (MODE == 1) {
#pragma unroll
            for (int tl = 0; tl < 2; ++tl) { const int n = kb * 8 + fq * 2 + tl; impL[fr * 64 + n] += (imps[tl][0] + imps[tl][1]) + (imps[tl][2] + imps[tl][3]); }
            LDS_WAIT();
#pragma unroll
            for (int tl = 0; tl < 2; ++tl) { const int n = kb * 8 + fq * 2 + tl + 1; if (n < 64) impL[fr * 64 + n] += imps[tl][3]; LDS_WAIT(); }
        }
    }
}

__device__ __forceinline__ void nsa_item(const KParams& P, LAS float* impL, int item, int lane) {
    asm volatile("" : "+v"(lane));
    const int fr = lane & 15, fq = lane >> 4;
    const int bg = item & 15, tt = 255 - (item >> 4), b = bg >> 1, g = bg & 1, t0 = tt * 16, t = t0 + fr;
    const bf16_t* proj = (const bf16_t*)(P.ws + O_PROJ);
    const size_t rowq = (size_t)(b * T + t) * LDP;
    const f32x4 zero4 = {0.f, 0.f, 0.f, 0.f};
    const float* qg = P.in[3];
    bf16x8 qf[4][2]; float slope2[4];
#pragma unroll
    for (int r = 0; r < 4; ++r) {
        const int hd = g * 4 + r;
        const bf16_t* qp = proj + rowq + CQ + hd * 64 + fq * 8;
        float f0[8], f1[8]; unpack8(*(const u32x4*)qp, f0); unpack8(*(const u32x4*)(qp + 32), f1);
        float ss = 0.f;
#pragma unroll
        for (int e = 0; e < 8; ++e) ss += f0[e] * f0[e] + f1[e] * f1[e];
        ss += __shfl_xor(ss, 16); ss += __shfl_xor(ss, 32);
        const float rs = rsqrtf(ss * (1.0f / 64.0f) + EPS) * (0.125f * LOG2E);
#pragma unroll
        for (int e = 0; e < 8; ++e) { f0[e] *= rs * qg[fq * 8 + e]; f1[e] *= rs * qg[32 + fq * 8 + e]; }
        qf[r][0] = pack8(f0); qf[r][1] = pack8(f1);
        slope2[r] = __builtin_amdgcn_exp2f(-(float)(hd + 1)) * LOG2E;
    }
    u32x2 acc[4][4];
#pragma unroll
    for (int dt = 0; dt < 4; ++dt)
#pragma unroll
        for (int r = 0; r < 4; ++r) acc[dt][r] = (u32x2){0u, 0u};
    float l[4]; f32x4 o[4][4];
#pragma unroll
    for (int i = 0; i < 16; ++i) impL[i * 64 + lane] = 0.f;
    LDS_WAIT();
    if (t0 >= 16) {
        const bf16_t* KCp = (const bf16_t*)(P.ws + O_KC) + (size_t)bg * 256 * 64;
        const bf16_t* VCp = (const bf16_t*)(P.ws + O_VCT) + (size_t)bg * 64 * 256;
        const int kb_hi = (t0 / 16 + 31) / 32;
#pragma unroll
        for (int r = 0; r < 4; ++r) { l[r] = 0.f;
#pragma unroll
            for (int dt = 0; dt < 4; ++dt) o[dt][r] = zero4; }
        nsa_branch<0>(KCp, VCp, 256, 0, kb_hi, qf, slope2, t, 0u, 0u, l, o, impL, fr, fq);
#pragma unroll
        for (int r = 0; r < 4; ++r) { l[r] += __shfl_xor(l[r], 16); l[r] += __shfl_xor(l[r], 32); l[r] = (l[r] > 0.f) ? 1.0f / l[r] : 0.f; }
        nsa_branch<1>(KCp, VCp, 256, 0, kb_hi, qf, slope2, t, 0u, 0u, l, o, impL, fr, fq);
#pragma unroll
        for (int r = 0; r < 4; ++r) { const float gt = sigmoidf_(bf2f(proj[rowq + CG + (g * 4 + r) * 3 + 0]));
#pragma unroll
            for (int dt = 0; dt < 4; ++dt) { u32x2 w; w.x = cvt_pk(o[dt][r][0] * gt, o[dt][r][1] * gt); w.y = cvt_pk(o[dt][r][2] * gt, o[dt][r][3] * gt); acc[dt][r] = w; } }
    }
    LDS_WAIT();
    unsigned selLo = 0u, selHi = 0u;
    if (t0 + 15 < 1024) selLo = (2u << (t >> 6)) - 1u;
    else
#pragma unroll 1
    for (int tau = 0; tau < 16; ++tau) {
        const int tq = t0 + tau; float v = impL[tau * 64 + lane];
        if (lane == (tq >> 6) || lane == 0) v = 1e9f; else if (64 * lane > tq) v = -1e9f;
        int rank = 0;
#pragma unroll 8
        for (int mi = 0; mi < 64; ++mi) { const float vm = __uint_as_float(__builtin_amdgcn_readlane(__float_as_uint(v), mi)); rank += ((vm > v) || (vm == v && mi < lane)) ? 1 : 0; }
        const unsigned long long msk = __ballot(rank < 16);
        if (fr == tau) { selLo = (unsigned)msk; selHi = (unsigned)(msk >> 32); }
    }
    {
        const bf16_t* Ks = (const bf16_t*)(P.ws + O_KSN) + (size_t)bg * T * 64;
        const bf16_t* Vs = (const bf16_t*)(P.ws + O_VST) + (size_t)bg * 64 * T;
#pragma unroll
        for (int r = 0; r < 4; ++r) { l[r] = 0.f;
#pragma unroll
            for (int dt = 0; dt < 4; ++dt) o[dt][r] = zero4; }
        nsa_branch<2>(Ks, Vs, T, 0, (t0 / 64 + 1) * 2, qf, slope2, t, selLo, selHi, l, o, impL, fr, fq);
#pragma unroll
        for (int r = 0; r < 4; ++r) { l[r] += __shfl_xor(l[r], 16); l[r] += __shfl_xor(l[r], 32);
            const float gt = sigmoidf_(bf2f(proj[rowq + CG + (g * 4 + r) * 3 + 1])); const float sc = (l[r] > 0.f) ? gt / l[r] : 0.f;
#pragma unroll
            for (int dt = 0; dt < 4; ++dt) { const u32x2 w = acc[dt][r];
                const f32x4 ov = (f32x4){__uint_as_float(w.x << 16), __uint_as_float(w.x & 0xffff0000u), __uint_as_float(w.y << 16), __uint_as_float(w.y & 0xffff0000u)} + o[dt][r] * sc;
                u32x2 w2; w2.x = cvt_pk(ov[0], ov[1]); w2.y = cvt_pk(ov[2], ov[3]); acc[dt][r] = w2; } }
    }
    {
        const bf16_t* Kw = (const bf16_t*)(P.ws + O_KWN) + (size_t)bg * T * 64;
        const bf16_t* Vw = (const bf16_t*)(P.ws + O_VWT) + (size_t)bg * 64 * T;
#pragma unroll
        for (int r = 0; r < 4; ++r) { l[r] = 0.f;
#pragma unroll
            for (int dt = 0; dt < 4; ++dt) o[dt][r] = zero4; }
        const int kb_lo = (t0 > 511) ? (t0 - 511) / 32 : 0;
        nsa_branch<3>(Kw, Vw, T, kb_lo, t0 / 32 + 1, qf, slope2, t, 0u, 0u, l, o, impL, fr, fq);
        bf16_t* Yp = (bf16_t*)(P.ws + O_Y) + (size_t)(b * T + t) * DM + g * 256;
#pragma unroll
        for (int r = 0; r < 4; ++r) { l[r] += __shfl_xor(l[r], 16); l[r] += __shfl_xor(l[r], 32);
            const float gt = sigmoidf_(bf2f(proj[rowq + CG + (g * 4 + r) * 3 + 2])); const float sc = (l[r] > 0.f) ? gt / l[r] : 0.f;
#pragma unroll
            for (int dt = 0; dt < 4; ++dt) { const u32x2 w = acc[dt][r];
                const f32x4 ov = (f32x4){__uint_as_float(w.x << 16), __uint_as_float(w.x & 0xffff0000u), __uint_as_float(w.y << 16), __uint_as_float(w.y & 0xffff0000u)} + o[dt][r] * sc;
                u32x2 w2; w2.x = cvt_pk(ov[0], ov[1]); w2.y = cvt_pk(ov[2], ov[3]); *(u32x2*)(Yp + r * 64 + dt * 16 + fq * 4) = w2; } }
    }
}

#ifndef PH_MASK
#define PH_MASK 1023
#endif
__global__ void __launch_bounds__(512) fwd_kernel(KParams P) {
    extern __shared__ __attribute__((aligned(16))) unsigned char lds_raw[];
    LAS unsigned char* lds = (LAS unsigned char*)lds_raw;
    cg::grid_group grid = cg::this_grid();
    const int G = gridDim.x, bx = blockIdx.x, NGW = G * 8;
    unsigned char* ws = P.ws;
#define GRID_SYNC() do { __syncthreads(); grid.sync(); } while (0)
#define FRESH_IDS int tid = threadIdx.x; asm volatile("" : "+v"(tid)); const int lane = tid & 63, wave = __builtin_amdgcn_readfirstlane(tid >> 6), gw = bx * 8 + wave; LAS float* scr = (LAS float*)(lds + wave * 16384); (void)lane; (void)gw; (void)scr;
#define WTIN ((bf16_t*)(ws + O_WTIN))
#define WTOUT ((bf16_t*)(ws + O_WTOUT))
#define WTGU ((bf16_t*)(ws + O_WTGU))
#define WTDN ((bf16_t*)(ws + O_WTDN))
#define WTC1 ((bf16_t*)(ws + O_WTC1))
#define WTC2 ((bf16_t*)(ws + O_WTC2))
#define WTMQK ((bf16_t*)(ws + O_WTMQK))
#define POSP ((float*)(ws + O_POSP))
#define POSB ((float*)(ws + O_POSB))
#define SSQ ((float*)(ws + O_SSQ))
#define DEN ((float*)(ws + O_DEN))
#define KC ((bf16_t*)(ws + O_KC))
#define VCT ((bf16_t*)(ws + O_VCT))
#define HC ((bf16_t*)(ws + O_HC))
#define XN ((bf16_t*)(ws + O_XN))
#define PROJ ((bf16_t*)(ws + O_PROJ))
#define UC ((bf16_t*)(ws + O_UC))
#define KSN ((bf16_t*)(ws + O_KSN))
#define KWN ((bf16_t*)(ws + O_KWN))
#define VST ((bf16_t*)(ws + O_VST))
#define VWT ((bf16_t*)(ws + O_VWT))
#define MVT ((bf16_t*)(ws + O_MVT))
#define MKT ((bf16_t*)(ws + O_MKT))
#define YB ((bf16_t*)(ws + O_Y))
#define MQK ((bf16_t*)((char*)P.out + OUT_MQK))

#if (PH_MASK >> 0) & 1
    {
        FRESH_IDS
        constexpr int I_IN = 16 * 89, I_OUT = 16 * 32, I_G = 16 * 88, I_D = 44 * 32, I_C1 = 32 * 8, I_C2 = 4 * 2, I_MQ = 4 * 8;
        constexpr int NIT = I_IN + I_OUT + 2 * I_G + I_D + 2 * I_C1 + 2 * I_C2 + 2 * I_MQ;
        constexpr int NIT0 = I_IN + 2 * I_C1 + 2 * I_C2 + 2 * I_MQ;
        for (int it = gw; it < NIT0; it += NGW) {
            int r = it;
            if (r < I_IN) { transpose_item(P.in[2], INW, WTIN, DM, 0, 0, nullptr, 1.f, scr, r, lane); continue; } r -= I_IN;
            if (r < I_C1) { transpose_item(P.in[8], 256, WTC1, 2048, 0, 0, nullptr, 1.f, scr, r, lane); continue; } r -= I_C1;
            if (r < I_C1) { transpose_item(P.in[10], 256, WTC1 + 256 * 2048, 2048, 0, 0, nullptr, 1.f, scr, r, lane); continue; } r -= I_C1;
            if (r < I_C2) { transpose_item(P.in[9], 64, WTC2, 256, 0, 0, nullptr, 1.f, scr, r, lane); continue; } r -= I_C2;
            if (r < I_C2) { transpose_item(P.in[11], 64, WTC2 + 64 * 256, 256, 0, 0, nullptr, 1.f, scr, r, lane); continue; } r -= I_C2;
            if (r < I_MQ) { const int h = r >> 3; transpose_item(P.in[14] + h * 16384, 128, WTMQK, 128, h * 256, 0, nullptr, 1.f, scr, r & 7, lane); continue; } r -= I_MQ;
            { const int h = r >> 3; transpose_item(P.in[15] + h * 16384, 128, WTMQK, 128, h * 256 + 128, 0, nullptr, 0.08838834764831845f, scr, r & 7, lane); }
        }
        for (int i = bx * 512 + tid; i < (LDP - INW) * DM / 8; i += G * 512) ((u32x4*)(WTIN + (size_t)INW * DM))[i] = (u32x4){0u, 0u, 0u, 0u};
        const float* x = P.in[0]; const float* g1 = P.in[1];
        for (int mrow = gw; mrow < M; mrow += NGW) {
            const f32x4* xr = (const f32x4*)(x + (size_t)mrow * DM) + lane; f32x4 v[4]; float s = 0.f;
#pragma unroll
            for (int j = 0; j < 4; ++j) { v[j] = xr[64 * j]; s += (v[j][0] * v[j][0] + v[j][1] * v[j][1]) + (v[j][2] * v[j][2] + v[j][3] * v[j][3]); }
            const float rs = rsqrtf(wave_sum(s) * (1.0f / DM) + EPS);
            u32x2* o8 = (u32x2*)(XN + (size_t)mrow * DM) + lane;
#pragma unroll
            for (int j = 0; j < 4; ++j) { const f32x4 gv = ((const f32x4*)g1)[lane + 64 * j]; u32x2 w; w.x = cvt_pk(v[j][0] * rs * gv[0], v[j][1] * rs * gv[1]); w.y = cvt_pk(v[j][2] * rs * gv[2], v[j][3] * rs * gv[3]); o8[64 * j] = w; }
        }
        for (int kb = bx; kb < 64; kb += G) { const int kv = tid >> 8, n = tid & 255; const float* w1 = P.in[kv ? 10 : 8]; const float* pos = P.in[7]; float acc = 0.f;
#pragma unroll 8
            for (int kk = 32 * kb; kk < 32 * kb + 32; ++kk) acc += pos[kk] * w1[(size_t)kk * 256 + n];
            POSP[kb * 512 + tid] = acc; }
    }
#endif
    GRID_SYNC();
#if (PH_MASK >> 1) & 1
    {
        FRESH_IDS
        pg8::Cfg g{DM, DM, DM, 128, 128}; pg8::Sched2D S; S.init(XN, WTIN, (size_t)256 * DM * 2, (size_t)256 * DM * 2, M / 256, LDP / 256, G, bx);
        EpiBf16<0> E{PROJ, LDP, nullptr};
        pg8::gemm_phase(lds, g, S, E);
    }
#endif
    GRID_SYNC();
#if (PH_MASK >> 3) & 1
    {
        FRESH_IDS
        const int ncmp = (G >= 64) ? 32 : G, first = (G >= 64) ? 32 : 0;
        float* POSBp = (float*)(ws + O_SSQ) + (size_t)bx * 512;
        if (bx < ncmp) { float acc = 0.f; for (int kb = 0; kb < 64; ++kb) acc += POSP[kb * 512 + tid]; POSBp[tid] = acc; }
        if (bx >= first) {
            const float* cw = P.in[12]; const float* cb = P.in[13];
            SchedMqk S0{(const char*)UC, (const char*)WTMQK, first, G, bx}; pg8::Unit uu;
            for (int i = 0; S0.next(i, uu); ++i) {
                const int c4 = uu.pn * 128 + (tid & 31) * 4, rg = uu.pm * 256 + (tid >> 5) * 16;
                const f32x4 w0 = *(const f32x4*)(cw + c4), w1 = *(const f32x4*)(cw + 512 + c4), w2 = *(const f32x4*)(cw + 1024 + c4), w3 = *(const f32x4*)(cw + 1536 + c4), bb = *(const f32x4*)(cb + c4);
                const f32x4 z4 = {0.f, 0.f, 0.f, 0.f};
                f32x4 u3 = z4, u2 = z4, u1 = z4;
                if ((rg & (T - 1)) != 0) {
                    const u32x2 a3 = *(const u32x2*)(PROJ + (size_t)(rg - 3) * LDP + CU + c4), a2 = *(const u32x2*)(PROJ + (size_t)(rg - 2) * LDP + CU + c4), a1 = *(const u32x2*)(PROJ + (size_t)(rg - 1) * LDP + CU + c4);
                    u3 = (f32x4){__uint_as_float(a3.x << 16), __uint_as_float(a3.x & 0xffff0000u), __uint_as_float(a3.y << 16), __uint_as_float(a3.y & 0xffff0000u)};
                    u2 = (f32x4){__uint_as_float(a2.x << 16), __uint_as_float(a2.x & 0xffff0000u), __uint_as_float(a2.y << 16), __uint_as_float(a2.y & 0xffff0000u)};
                    u1 = (f32x4){__uint_as_float(a1.x << 16), __uint_as_float(a1.x & 0xffff0000u), __uint_as_float(a1.y << 16), __uint_as_float(a1.y & 0xffff0000u)}; }
#pragma unroll 4
                for (int r = 0; r < 16; ++r) { const u32x2 a0 = *(const u32x2*)(PROJ + (size_t)(rg + r) * LDP + CU + c4);
                    const f32x4 u0 = {__uint_as_float(a0.x << 16), __uint_as_float(a0.x & 0xffff0000u), __uint_as_float(a0.y << 16), __uint_as_float(a0.y & 0xffff0000u)};
                    const f32x4 yv = w0 * u3 + w1 * u2 + w2 * u1 + w3 * u0 + bb;
                    u32x2 o; o.x = cvt_pk(siluf_(yv[0]), siluf_(yv[1])); o.y = cvt_pk(siluf_(yv[2]), siluf_(yv[3])); *(u32x2*)(UC + (size_t)(rg + r) * 512 + c4) = o;
                    u3 = u2; u2 = u1; u1 = u0; }
            }
        }
        asm volatile("s_waitcnt vmcnt(0)" ::: "memory");
        __syncthreads();
        { pg8::Cfg g{2048, 16 * LDP, 2048, LDP * 2, 128}; SchedCmp S{(const char*)PROJ, (const char*)WTC1, ncmp, bx}; EpiBf16<1> E{HC, 256, POSBp}; pg8::gemm_phase(lds, g, S, E); }
        { pg8::Cfg g{128, 512, 128, 128, 128}; SchedMqk S{(const char*)UC, (const char*)WTMQK, first, G, bx}; EpiBf16<0> E{MQK, 1024, nullptr}; pg8::gemm_phase(lds, g, S, E); }
        if (bx >= first) {
            __syncthreads();
            const int gw2 = (bx - first) * 8 + wave, NGW2 = (G - first) * 8;
        for (int mrow = gw2; mrow < M; mrow += NGW2) {
            const int which = lane >> 4, c4 = (lane & 15) * 4, col = (which < 2 ? CKS : CKW) + (which & 1) * 64 + c4;
            const u32x2 w = *(const u32x2*)(PROJ + (size_t)mrow * LDP + col);
            float f[4] = {__uint_as_float(w.x << 16), __uint_as_float(w.x & 0xffff0000u), __uint_as_float(w.y << 16), __uint_as_float(w.y & 0xffff0000u)};
            float ss = (f[0] * f[0] + f[1] * f[1]) + (f[2] * f[2] + f[3] * f[3]);
            ss += __shfl_xor(ss, 1); ss += __shfl_xor(ss, 2); ss += __shfl_xor(ss, 4); ss += __shfl_xor(ss, 8);
            const float rs = rsqrtf(ss * (1.0f / 64.0f) + EPS); const float* gn = P.in[which < 2 ? 5 : 6] + c4;
            const int b = mrow / T, t = mrow % T;
            u32x2 ov; ov.x = cvt_pk(f[0] * rs * gn[0], f[1] * rs * gn[1]); ov.y = cvt_pk(f[2] * rs * gn[2], f[3] * rs * gn[3]);
            { const int kb = t >> 5, wi = t & 31, tl = (wi >> 2) & 1, frr = ((wi >> 3) << 2) | (wi & 3), ks = c4 >> 5, fqq = (c4 & 31) >> 3, e = c4 & 7;
              *(u32x2*)((which < 2 ? KSN : KWN) + (size_t)(b * 2 + (which & 1)) * T * 64 + ((size_t)(((kb * 2 + tl) * 2 + ks) * 64 + fqq * 16 + frr)) * 8 + e) = ov; }
        }
        for (int it = gw2; it < NB * 64 * 12; it += NGW2) {
            const int grp = it % 12, rest = it / 12, tti = rest & 63, b = rest >> 6;
            int col; bf16_t* dst;
            if (grp < 2) { col = CVS + grp * 64; dst = VST + (size_t)(b * 2 + grp) * 64 * T; }
            else if (grp < 4) { col = CVW + (grp - 2) * 64; dst = VWT + (size_t)(b * 2 + grp - 2) * 64 * T; }
            else { col = CVM + (grp - 4) * 64; dst = MVT + ((size_t)b * 512 + (grp - 4) * 64) * T; }
            if (grp < 4) tr64(PROJ + (size_t)(b * T + tti * 64) * LDP + col, LDP, dst, T, (LAS bf16_t*)scr, lane, 1, tti);
            else tr64(PROJ + (size_t)(b * T + tti * 64) * LDP + col, LDP, MVT + (size_t)(b * 4 + ((grp - 4) >> 1)) * 128 * T, T, (LAS bf16_t*)scr, lane, 2 | (((grp - 4) & 1) << 8), tti);
        }
        }
        asm volatile("s_waitcnt vmcnt(0)" ::: "memory");
        __syncthreads();
        {
        const f32x4 zero4 = {0.f, 0.f, 0.f, 0.f};
        const int fr = lane & 15, fq = lane >> 4;
        if (bx < ncmp) for (int L_ = bx; L_ < 32; L_ += ncmp) for (int rt_ = wave; rt_ < 16; rt_ += 8) { const int it = L_ * 16 + rt_;
            const int L = it >> 4, rt = it & 15, kv = L >> 4, bgi = (L & 7) * 2 + ((L >> 3) & 1);
            const bf16_t* Hp = HC + ((size_t)L * 256 + rt * 16 + fr) * 256 + fq * 8;
            const bf16_t* Wp = WTC2 + (size_t)kv * 64 * 256 + (size_t)fr * 256 + fq * 8;
            f32x4 acc[4] = {zero4, zero4, zero4, zero4};
#pragma unroll
            for (int ks = 0; ks < 8; ++ks) { const bf16x8 hf = *(const bf16x8*)(Hp + 32 * ks);
#pragma unroll
                for (int nt = 0; nt < 4; ++nt) { const bf16x8 wf = *(const bf16x8*)(Wp + (size_t)nt * 16 * 256 + 32 * ks);
                    acc[nt] = (kv == 0) ? MFMA16(wf, hf, acc[nt]) : MFMA16(hf, wf, acc[nt]); } }
            if (kv == 0) {
                float ss = 0.f;
#pragma unroll
                for (int nt = 0; nt < 4; ++nt) ss += (acc[nt][0] * acc[nt][0] + acc[nt][1] * acc[nt][1]) + (acc[nt][2] * acc[nt][2] + acc[nt][3] * acc[nt][3]);
                ss += __shfl_xor(ss, 16); ss += __shfl_xor(ss, 32);
                float rs = rsqrtf(ss * (1.0f / 64.0f) + EPS); const int j = rt * 16 + fr; if (j == 255) rs = 0.f;
                const float* gn = P.in[4];
#pragma unroll
                for (int nt = 0; nt < 4; ++nt) { const int n = 16 * nt + 4 * fq; u32x2 w; w.x = cvt_pk(acc[nt][0] * rs * gn[n], acc[nt][1] * rs * gn[n + 1]); w.y = cvt_pk(acc[nt][2] * rs * gn[n + 2], acc[nt][3] * rs * gn[n + 3]);
                    { const int kb = j >> 5, wi = j & 31, tl = (wi >> 2) & 1, frr = ((wi >> 3) << 2) | (wi & 3), ks = n >> 5, fqq = (n & 31) >> 3, e = n & 7;
                      *(u32x2*)(KC + (size_t)bgi * 256 * 64 + ((size_t)(((kb * 2 + tl) * 2 + ks) * 64 + fqq * 16 + frr)) * 8 + e) = w; } }
            } else {
#pragma unroll
                for (int nt = 0; nt < 4; ++nt) { const int j0 = rt * 16 + 4 * fq; const float v3 = (j0 + 3 == 255) ? 0.f : acc[nt][3];
                    u32x2 w; w.x = cvt_pk(acc[nt][0], acc[nt][1]); w.y = cvt_pk(acc[nt][2], v3);
                    { const int kb = j0 >> 5, fqq = (j0 & 31) >> 3, e = j0 & 7;
                      *(u32x2*)(VCT + (size_t)bgi * 64 * 256 + ((size_t)((kb * 4 + nt) * 64 + fqq * 16 + fr)) * 8 + e) = w; } }
            }
        }
        if (bx >= first) {
            SchedMqk S1{(const char*)UC, (const char*)WTMQK, first, G, bx}; pg8::Unit uu;
            for (int i = 0; S1.next(i, uu); ++i) {
                const int h = uu.pn, b = uu.pm >> 4, tti0 = (uu.pm & 15) * 4;
                { const int tti = tti0 + (wave >> 1), half = wave & 1;
                  tr64(MQK + (size_t)(b * T + tti * 64) * 1024 + h * 256 + 128 + half * 64, 1024, MKT + (size_t)(b * 4 + h) * 128 * T, T, (LAS bf16_t*)scr, lane, 2 | (half << 8), tti); }
#pragma unroll 1
                for (int j = 0; j < 4; ++j) if (((i * 4 + j) & 7) == wave) mlstm_ploc(P, (b * 4 + h) * 64 + tti0 + j, lane);
            }
        }
        }
    }
#endif
    GRID_SYNC();
#if (PH_MASK >> 5) & 1
    {
        FRESH_IDS
        unsigned* ctr = (unsigned*)(ws + O_CTL);
        for (;;) {
            unsigned it = 0; if (lane == 0) it = atomicAdd(ctr, 1u);
            it = __builtin_amdgcn_readfirstlane(it);
            if (it >= (unsigned)N_ML) break;
            mlstm_unit(P, (int)it, lane);
        }
        for (int dx = 0; dx < 8; ++dx) {
            const int x = (bx + dx) & 7; unsigned* q = ctr + 32 * (1 + x);
            for (;;) {
                unsigned it = 0; if (lane == 0) it = atomicAdd(q, 1u);
                it = __builtin_amdgcn_readfirstlane(it);
                if (it >= 512u) break;
                nsa_item(P, scr, (int)(((it & 255u) << 4) | (2u * x + (it >> 8))), lane);
            }
        }
        {
            constexpr int I_OUT = 16 * 32, I_G = 16 * 88, I_D = 44 * 32, NITF = I_OUT + 2 * I_G + I_D;
            unsigned* qf_ = ctr + 32 * 10;
            for (;;) {
                unsigned it = 0; if (lane == 0) it = atomicAdd(qf_, 1u);
                it = __builtin_amdgcn_readfirstlane(it);
                if (it >= (unsigned)NITF) break;
                int r = (int)it;
                if (r < I_OUT) { transpose_item(P.in[20], DM, WTOUT, DM, 0, 0, nullptr, 1.f, scr, r, lane); continue; } r -= I_OUT;
                if (r < I_G) { transpose_item(P.in[22], FF, WTGU, DM, 0, 1, P.in[21], 1.f, scr, r, lane); continue; } r -= I_G;
                if (r < I_G) { transpose_item(P.in[23], FF, WTGU, DM, 0, 2, P.in[21], 1.f, scr, r, lane); continue; } r -= I_G;
                transpose_item(P.in[24], DM, WTDN, FF, 0, 0, nullptr, 1.f, scr, r, lane);
            }
        }
    }
#endif
    GRID_SYNC();
#if (PH_MASK >> 6) & 1
    {
        FRESH_IDS
        const float* NUM = P.out; const float* ng = P.in[18]; const float* sk = P.in[19];
        for (int idx = gw * 4 + (lane >> 4); idx < M * 4; idx += NGW * 4) {
            const int mrow = idx >> 2, h = idx & 3, b = mrow / T, t = mrow % T, c = h * 128 + 8 * (lane & 15);
            const f32x4 n0 = *(const f32x4*)(NUM + (size_t)mrow * 512 + c), n1 = *(const f32x4*)(NUM + (size_t)mrow * 512 + c + 4);
            const float rd = 1.0f / DEN[(size_t)(b * 4 + h) * T + t];
            float og[8], uf[8]; unpack8(*(const u32x4*)(PROJ + (size_t)mrow * LDP + CO + c), og); unpack8(*(const u32x4*)(UC + (size_t)mrow * 512 + c), uf);
            float hv[8]; float ss = 0.f;
#pragma unroll
            for (int e = 0; e < 4; ++e) { hv[e] = n0[e] * rd * sigmoidf_(og[e]); hv[4 + e] = n1[e] * rd * sigmoidf_(og[4 + e]); }
#pragma unroll
            for (int e = 0; e < 8; ++e) ss += hv[e] * hv[e];
            ss += __shfl_xor(ss, 1); ss += __shfl_xor(ss, 2); ss += __shfl_xor(ss, 4); ss += __shfl_xor(ss, 8);
            const float rs = rsqrtf(ss * (1.0f / 128.0f) + EPS);
            const f32x4 g0 = *(const f32x4*)(ng + c), g1 = *(const f32x4*)(ng + c + 4), s0 = *(const f32x4*)(sk + c), s1 = *(const f32x4*)(sk + c + 4);
            float y[8];
#pragma unroll
            for (int e = 0; e < 4; ++e) { y[e] = hv[e] * rs * g0[e] + s0[e] * uf[e]; y[4 + e] = hv[4 + e] * rs * g1[e] + s1[e] * uf[4 + e]; }
            *(bf16x8*)(YB + (size_t)mrow * DM + 512 + c) = pack8(y);
        }
    }
#endif
    GRID_SYNC();
#if (PH_MASK >> 7) & 1
    {
        FRESH_IDS
        pg8::Cfg g{DM, DM, DM, 128, 128}; pg8::Sched2D S; S.init(YB, WTOUT, (size_t)256 * DM * 2, (size_t)256 * DM * 2, M / 256, DM / 256, G, bx);
        EpiOut E{P.in[0], P.out, XN, SSQ};
        pg8::gemm_phase(lds, g, S, E);
    }
#endif
    GRID_SYNC();
#if (PH_MASK >> 8) & 1
    {
        FRESH_IDS
        pg8::Cfg g{DM, DM, DM, 128, 128}; pg8::Sched2D S; S.init(XN, WTGU, (size_t)256 * DM * 2, (size_t)256 * DM * 2, M / 256, 2 * FF / 256, G, bx);
        EpiGU E{PROJ, SSQ};
        pg8::gemm_phase(lds, g, S, E);
    }
#endif
    GRID_SYNC();
#if (PH_MASK >> 9) & 1
    {
        FRESH_IDS
        pg8::Cfg g{FF, FF, FF, 128, 128}; pg8::Sched2D S; S.init(PROJ, WTDN, (size_t)256 * FF * 2, (size_t)256 * FF * 2, M / 256, DM / 256, G, bx);
        EpiDown E{P.out};
        pg8::gemm_phase(lds, g, S, E);
    }
#endif
}

extern "C" void kernel_launch(void* const* d_in, const int* in_sizes, int n_in, void* d_out, int out_size, void* d_ws, size_t ws_size, hipStream_t stream) {
    static int grid = 0;
    if (grid == 0) {
        if (n_in != 25 || out_size != M * DM || ws_size < O_END) { fprintf(stderr, "kernel_launch: unexpected shapes (n_in %d, out %d, ws %zu < %zu)\n", n_in, out_size, ws_size, (size_t)O_END); grid = -1; return; }
        int dev = 0, cus = 0, per_cu = 0;
        hipGetDevice(&dev); hipDeviceGetAttribute(&cus, hipDeviceAttributeMultiprocessorCount, dev);
        if (hipFuncSetAttribute((const void*)fwd_kernel, hipFuncAttributeMaxDynamicSharedMemorySize, LDS_BYTES) != hipSuccess) { fprintf(stderr, "kernel_launch: hipFuncSetAttribute failed\n"); grid = -1; return; }
        if (hipOccupancyMaxActiveBlocksPerMultiprocessor(&per_cu, (const void*)fwd_kernel, 512, LDS_BYTES) != hipSuccess || per_cu < 1) { fprintf(stderr, "kernel_launch: occupancy query gave %d\n", per_cu); (void)hipGetLastError(); grid = -1; return; }
        grid = cus;
    }
    if (grid < 0) return;
    (void)hipMemsetAsync((char*)d_ws + O_CTL, 0, 4096, stream);
    KParams p{};
    for (int i = 0; i < 25; ++i) p.in[i] = (const float*)d_in[i];
    p.out = (float*)d_out; p.ws = (unsigned char*)d_ws;
    void* args[] = {&p};
    hipError_t e = hipLaunchCooperativeKernel((const void*)fwd_kernel, dim3(grid), dim3(512), args, LDS_BYTES, stream);
    if (e != hipSuccess) fprintf(stderr, "cooperative launch failed: %s (grid %d)\n", hipGetErrorString(e), grid);
}
```

```cpp
#include <hip/hip_runtime.h>
#include <hip/hip_cooperative_groups.h>
#include <cstdio>
#include <cstdint>
namespace cg = cooperative_groups;

#define LAS __attribute__((address_space(3)))
typedef unsigned short bf16_t;
typedef short bf16x8 __attribute__((ext_vector_type(8)));
typedef float f32x4 __attribute__((ext_vector_type(4)));
typedef float f32x2 __attribute__((ext_vector_type(2)));
typedef unsigned u32x4 __attribute__((ext_vector_type(4)));
typedef unsigned u32x2 __attribute__((ext_vector_type(2)));

constexpr int NB = 8, T = 4096, DM = 1024, M = NB * T, LDP = 3072, FF = 2816;
constexpr int CQ = 0, CKC = 512, CVC = 640, CKS = 768, CVS = 896, CKW = 1024, CVW = 1152, CG = 1280, CU = 1304, CVM = 1816, CO = 2328, CI = 2840, CF = 2844, INW = 2848;
constexpr float EPS = 1e-6f, LOG2E = 1.4426950408889634f;

constexpr size_t al(size_t x) { return (x + 255) & ~(size_t)255; }
constexpr size_t O_CTL = 0;
constexpr size_t O_WTIN = 65536;
constexpr size_t O_WTOUT = O_WTIN + al((size_t)LDP * DM * 2);
constexpr size_t O_WTGU = O_WTOUT + al((size_t)DM * DM * 2);
constexpr size_t O_WTDN = O_WTGU + al((size_t)2 * FF * DM * 2);
constexpr size_t O_WTC1 = O_WTDN + al((size_t)DM * FF * 2);
constexpr size_t O_WTC2 = O_WTC1 + al((size_t)2 * 256 * 2048 * 2);
constexpr size_t O_WTMQK = O_WTC2 + al((size_t)2 * 64 * 256 * 2);
constexpr size_t O_POSP = O_WTMQK + al((size_t)4 * 256 * 128 * 2);
constexpr size_t O_POSB = O_POSP + al((size_t)64 * 512 * 4);
constexpr size_t O_SSQ = O_POSB + al((size_t)512 * 4);
constexpr size_t O_DEN = O_SSQ + al((size_t)M * 16 * 4);
constexpr size_t O_KC = O_DEN + al((size_t)32 * T * 4);
constexpr size_t O_VCT = O_KC + al((size_t)16 * 256 * 64 * 2);
constexpr size_t O_HC = O_VCT + al((size_t)16 * 64 * 256 * 2);
constexpr size_t O_XN = O_HC + al((size_t)32 * 256 * 256 * 2);
constexpr size_t O_PROJ = O_XN + al((size_t)M * DM * 2);
constexpr size_t O_UC = O_PROJ + al((size_t)(M + 64) * LDP * 2);
constexpr size_t O_KSN = O_UC + al((size_t)M * 512 * 2);
constexpr size_t O_KWN = O_KSN + al((size_t)16 * T * 64 * 2);
constexpr size_t O_VST = O_KWN + al((size_t)16 * T * 64 * 2);
constexpr size_t O_VWT = O_VST + al((size_t)16 * T * 64 * 2);
constexpr size_t O_MVT = O_VWT + al((size_t)16 * T * 64 * 2);
constexpr size_t O_MKT = O_MVT + al((size_t)32 * 128 * T * 2);
constexpr size_t O_Y = O_MKT + al((size_t)32 * 128 * T * 2);
constexpr size_t O_PB = O_Y + al((size_t)M * DM * 2);
constexpr size_t O_GT = O_PB + al((size_t)32 * 64 * 4 * 2 * 64 * 16);
constexpr size_t O_END = O_GT + al((size_t)32 * 64 * 3 * 64 * 4);
constexpr size_t OUT_MQK = (size_t)M * 512 * 4;

constexpr int LDS_BYTES = 131072 + 4096;
constexpr int N_ML = 288, N_NSA = 4096;

struct KParams { const float* in[25]; float* out; unsigned char* ws; };

__device__ __forceinline__ float bf2f(unsigned short h) { return __uint_as_float(((unsigned)h) << 16); }
__device__ __forceinline__ unsigned cvt_pk(float lo, float hi) { unsigned r; asm("v_cvt_pk_bf16_f32 %0, %1, %2" : "=v"(r) : "v"(lo), "v"(hi)); return r; }
__device__ __forceinline__ unsigned short f2bf(float f) { return (unsigned short)(cvt_pk(f, 0.f) & 0xffffu); }
__device__ __forceinline__ void unpack8(const u32x4 w, float* f) {
#pragma unroll
    for (int i = 0; i < 4; ++i) { f[2 * i] = __uint_as_float(w[i] << 16); f[2 * i + 1] = __uint_as_float(w[i] & 0xffff0000u); }
}
__device__ __forceinline__ bf16x8 pack8(const float* f) {
    u32x4 w; w.x = cvt_pk(f[0], f[1]); w.y = cvt_pk(f[2], f[3]); w.z = cvt_pk(f[4], f[5]); w.w = cvt_pk(f[6], f[7]);
    return __builtin_bit_cast(bf16x8, w);
}
__device__ __forceinline__ float sigmoidf_(float x) { return 1.0f / (1.0f + __expf(-x)); }
__device__ __forceinline__ float siluf_(float x) { return x * sigmoidf_(x); }
__device__ __forceinline__ float gelu_tanh(float x) { const float u = 0.7978845608028654f * (x + 0.044715f * x * x * x); const float e = __expf(2.0f * u); const float th = 1.0f - 2.0f / (e + 1.0f); return 0.5f * x * (1.0f + th); }
#define LDS_WAIT() asm volatile("s_waitcnt lgkmcnt(0)" ::: "memory")
#define MFMA16(a, b, c) __builtin_amdgcn_mfma_f32_16x16x32_bf16((a), (b), (c), 0, 0, 0)

namespace pg8 {
constexpr int BM = 256, BK = 64, HALF = 128, HTB = HALF * BK * 2, STAGE_BYTES = 8 * HTB;
__device__ __forceinline__ int lds_byte(int r, int c) { const int st = (r >> 4) * 2 + (c >> 5), rr = r & 15, cc = c & 31, ob = rr * 64 + cc * 2; return st * 1024 + (ob ^ (((ob >> 9) & 1) << 5)); }
__device__ __forceinline__ void stage_rc(int b, int& R, int& C) { const int st = b / 1024, sb = b % 1024, swz = sb ^ (((sb >> 9) & 1) << 5); R = (st >> 1) * 16 + swz / 64; C = (st & 1) * 32 + (swz % 64) / 2; }
__device__ __forceinline__ int perm32(int rho) { const int n = rho >> 4, i = rho & 15; return 8 * (i >> 2) + 4 * n + (i & 3); }
struct Unit { int pm, pn; const char* A; const char* B; };
struct Cfg { int K, lda, ldb, kstepA, kstepB; };

template <class Epi, class Sched>
__device__ __forceinline__ void gemm_phase(LAS unsigned char* lds, const Cfg g, const Sched& S, const Epi& E) {
    int tid = threadIdx.x; asm volatile("" : "+v"(tid)); const int wid = __builtin_amdgcn_readfirstlane(tid >> 6), lane = tid & 63, wr = wid >> 2, wc = wid & 3, fr = lane & 15, fq = lane >> 4;
    const int nt = g.K / BK;
    unsigned voffA[2], voffB[2];
#pragma unroll
    for (int i = 0; i < 2; ++i) { int R, C; stage_rc(tid * 16 + i * 8192, R, C); const int Rb = Epi::PERM ? ((R & ~31) + perm32(R & 31)) : R;
        voffA[i] = (unsigned)(R * g.lda + C) * 2u; voffB[i] = (unsigned)(Rb * g.ldb + C) * 2u; }
    const size_t kstepA = (size_t)g.kstepA, kstepB = (size_t)g.kstepB;
    const size_t hstepA = (size_t)HALF * g.lda * 2, hstepB = (size_t)HALF * g.ldb * 2;
    const unsigned ldsw = (unsigned)wid * 1024u;
    const int aoff = lds_byte(wr * 64 + fr, fq * 8), boff = lds_byte(wc * 32 + fr, fq * 8);
#define PG8_SA(b, h) (((b) * 2 + (h)) * HTB)
#define PG8_SB(b, h) ((4 + (b) * 2 + (h)) * HTB)
#define PG8_STAGE(bufoff, gbase, voff) do { _Pragma("unroll") for (int _i = 0; _i < 2; ++_i) \
        __builtin_amdgcn_global_load_lds((const unsigned*)((const char*)(gbase) + (voff)[_i]), (LAS unsigned*)(lds + (bufoff) + ldsw + _i * 8192), 16, 0, 0); } while (0)
#define PG8_LDA(dst, b, h) do { _Pragma("unroll") for (int m = 0; m < 4; ++m) _Pragma("unroll") for (int k = 0; k < 2; ++k) dst[m][k] = *(const LAS bf16x8*)(lds + PG8_SA(b, h) + aoff + m * 2048 + k * 1024); } while (0)
#define PG8_LDB(dst, b, h) do { _Pragma("unroll") for (int n = 0; n < 2; ++n) _Pragma("unroll") for (int k = 0; k < 2; ++k) dst[n][k] = *(const LAS bf16x8*)(lds + PG8_SB(b, h) + boff + n * 2048 + k * 1024); } while (0)
#define PG8_MMA(ai, bj, At, Bt) do { __builtin_amdgcn_s_setprio(1); _Pragma("unroll") for (int m = 0; m < 4; ++m) _Pragma("unroll") for (int n = 0; n < 2; ++n) _Pragma("unroll") for (int k = 0; k < 2; ++k) \
        acc[ai][bj][m][n] = __builtin_amdgcn_mfma_f32_16x16x32_bf16(Bt[n][k], At[m][k], acc[ai][bj][m][n], 0, 0, 0); __builtin_amdgcn_s_setprio(0); } while (0)
#define PG8_WAIT_V(n) asm volatile("s_waitcnt vmcnt(" #n ")" ::: "memory")
#define PG8_WAIT_L(n) asm volatile("s_waitcnt lgkmcnt(" #n ")" ::: "memory")
#define PG8_BAR __builtin_amdgcn_s_barrier()
#define PG8_SCHED __builtin_amdgcn_sched_barrier(0)
    Unit cur, nxt; int ui = 0;
    if (!S.next(0, cur)) return;
    f32x4 acc[2][2][4][2];
#pragma unroll
    for (int a = 0; a < 2; ++a)
#pragma unroll
        for (int b = 0; b < 2; ++b)
#pragma unroll
            for (int m = 0; m < 4; ++m)
#pragma unroll
                for (int n = 0; n < 2; ++n) acc[a][b][m][n] = (f32x4){0.f, 0.f, 0.f, 0.f};
    bf16x8 At[4][2], B0[2][2], B1[2][2];
    const char* cA = cur.A; const char* cB = cur.B;
    PG8_STAGE(PG8_SB(0, 0), cB, voffB); PG8_STAGE(PG8_SB(0, 1), cB + hstepB, voffB); PG8_STAGE(PG8_SA(0, 0), cA, voffA); PG8_STAGE(PG8_SA(0, 1), cA + hstepA, voffA);
    if (wr == 1) PG8_BAR;
    PG8_WAIT_V(2); PG8_BAR;
    PG8_STAGE(PG8_SB(1, 0), cB + kstepB, voffB); PG8_STAGE(PG8_SA(1, 0), cA + kstepA, voffA); PG8_STAGE(PG8_SB(1, 1), cB + hstepB + kstepB, voffB);
    PG8_WAIT_V(6); PG8_BAR;
    for (;;) {
        const bool has_next = S.next(ui + 1, nxt);
        const char* nA = has_next ? nxt.A : cA; const char* nB = has_next ? nxt.B : cB;
        for (int t = 0; t < nt; t += 2) {
            const bool last = (t == nt - 2);
            const char* a1 = cA + (size_t)(t + 1) * kstepA;
            const char* a2 = last ? nA : cA + (size_t)(t + 2) * kstepA; const char* b2 = last ? nB : cB + (size_t)(t + 2) * kstepB;
            const char* a3 = a2 + kstepA; const char* b3 = b2 + kstepB;
            PG8_LDB(B0, 0, 0); PG8_LDB(B1, 0, 1); PG8_SCHED; PG8_LDA(At, 0, 0); PG8_STAGE(PG8_SA(1, 1), a1 + hstepA, voffA);
            PG8_WAIT_V(8); PG8_WAIT_L(0); PG8_BAR; PG8_MMA(0, 0, At, B0); PG8_MMA(0, 1, At, B1); PG8_BAR; PG8_SCHED;
            PG8_LDA(At, 0, 1); PG8_STAGE(PG8_SB(0, 0), b2, voffB); PG8_STAGE(PG8_SB(0, 1), b2 + hstepB, voffB); PG8_STAGE(PG8_SA(0, 0), a2, voffA);
            PG8_WAIT_V(8); PG8_WAIT_L(0); PG8_BAR; PG8_MMA(1, 0, At, B0); PG8_MMA(1, 1, At, B1); PG8_BAR; PG8_SCHED;
            PG8_LDB(B0, 1, 0); PG8_LDB(B1, 1, 1); PG8_SCHED; PG8_LDA(At, 1, 0); PG8_STAGE(PG8_SA(0, 1), a2 + hstepA, voffA);
            PG8_WAIT_V(8); PG8_WAIT_L(0); PG8_BAR; PG8_MMA(0, 0, At, B0); PG8_MMA(0, 1, At, B1); PG8_BAR; PG8_SCHED;
            PG8_LDA(At, 1, 1); PG8_STAGE(PG8_SB(1, 0), b3, voffB); PG8_STAGE(PG8_SB(1, 1), b3 + hstepB, voffB); PG8_STAGE(PG8_SA(1, 0), a3, voffA);
            PG8_WAIT_V(8); PG8_WAIT_L(0); PG8_BAR; PG8_MMA(1, 0, At, B0); PG8_MMA(1, 1, At, B1); PG8_BAR; PG8_SCHED;
        }
        if (wr == 0) PG8_BAR;
        E(acc, cur, wr, wc, fr, fq);
        if (!has_next) break;
#pragma unroll
        for (int a = 0; a < 2; ++a)
#pragma unroll
            for (int b = 0; b < 2; ++b)
#pragma unroll
                for (int m = 0; m < 4; ++m)
#pragma unroll
                    for (int n = 0; n < 2; ++n) acc[a][b][m][n] = (f32x4){0.f, 0.f, 0.f, 0.f};
        cur = nxt; cA = nA; cB = nB; ++ui;
        if (wr == 1) PG8_BAR;
    }
    PG8_WAIT_V(0);
    PG8_BAR;
#undef PG8_SA
#undef PG8_SB
#undef PG8_STAGE
#undef PG8_LDA
#undef PG8_LDB
#undef PG8_MMA
#undef PG8_WAIT_V
#undef PG8_WAIT_L
#undef PG8_BAR
#undef PG8_SCHED
}

struct Sched2D {
    const char* A; const char* B; size_t tA, tB; int nM, nN, nwg, G, c;
    __device__ void init(const void* A_, const void* B_, size_t tA_, size_t tB_, int nM_, int nN_, int G_, int c_) { A = (const char*)A_; B = (const char*)B_; tA = tA_; tB = tB_; nM = nM_; nN = nN_; nwg = nM * nN; G = G_; c = c_; }
    __device__ bool next(int i, Unit& u) const {
        const long L = (long)i * G + c; if (L >= nwg) return false;
        int wgid = (int)L; { const int q = nwg / 8, r = nwg % 8, xcd = wgid % 8, off = wgid / 8; wgid = (xcd < r ? xcd * (q + 1) : r * (q + 1) + (xcd - r) * q) + off; }
        const int nig = 8 * nN, gid = wgid / nig, fm = gid * 8, gsz = (nM - fm) < 8 ? (nM - fm) : 8;
        u.pm = fm + ((wgid % nig) % gsz); u.pn = (wgid % nig) / gsz; u.A = A + (size_t)u.pm * tA; u.B = B + (size_t)u.pn * tB; return true;
    }
};
}

template <int ACT> struct EpiBf16 {
    static constexpr bool PERM = true;
    bf16_t* O; int ldc; const float* bias;
    __device__ __forceinline__ void operator()(const f32x4 (&acc)[2][2][4][2], const pg8::Unit& u, int wr, int wc, int fr, int fq) const {
        const int row0 = u.pm * 256 + wr * 64 + fr, col0 = u.pn * 256 + wc * 32 + 8 * fq;
#pragma unroll
        for (int ai = 0; ai < 2; ++ai)
#pragma unroll
            for (int m = 0; m < 4; ++m) { bf16_t* rowp = O + (size_t)(row0 + ai * 128 + m * 16) * ldc + col0;
#pragma unroll
                for (int bj = 0; bj < 2; ++bj) { f32x4 v0 = acc[ai][bj][m][0], v1 = acc[ai][bj][m][1];
                    if (ACT == 1) { const float* bp = bias + (u.pm >> 4) * 256 + wc * 32 + 8 * fq + bj * 128;
#pragma unroll
                        for (int e = 0; e < 4; ++e) { v0[e] = gelu_tanh(v0[e] + bp[e]); v1[e] = gelu_tanh(v1[e] + bp[4 + e]); } }
                    u32x4 w; w.x = cvt_pk(v0[0], v0[1]); w.y = cvt_pk(v0[2], v0[3]); w.z = cvt_pk(v1[0], v1[1]); w.w = cvt_pk(v1[2], v1[3]);
                    *(u32x4*)(rowp + bj * 128) = w; } }
    }
};
struct EpiOut {
    static constexpr bool PERM = false;
    const float* X; float* O; bf16_t* XB; float* SSQ;
    __device__ __forceinline__ void operator()(const f32x4 (&acc)[2][2][4][2], const pg8::Unit& u, int wr, int wc, int fr, int fq) const {
        const int col0 = u.pn * 256 + wc * 32 + 4 * fq;
#pragma unroll
        for (int ai = 0; ai < 2; ++ai)
#pragma unroll
            for (int m = 0; m < 4; ++m) { const int row = u.pm * 256 + ai * 128 + wr * 64 + m * 16 + fr; const size_t off = (size_t)row * DM + col0; float ss = 0.f;
#pragma unroll
                for (int bj = 0; bj < 2; ++bj)
#pragma unroll
                    for (int n = 0; n < 2; ++n) { const f32x4 xv = *(const f32x4*)(X + off + bj * 128 + n * 16); const f32x4 v = xv + acc[ai][bj][m][n];
                        *(f32x4*)(O + off + bj * 128 + n * 16) = v; u32x2 w; w.x = cvt_pk(v[0], v[1]); w.y = cvt_pk(v[2], v[3]); *(u32x2*)(XB + off + bj * 128 + n * 16) = w;
                        ss += (v[0] * v[0] + v[1] * v[1]) + (v[2] * v[2] + v[3] * v[3]); }
                ss += __shfl_xor(ss, 16); ss += __shfl_xor(ss, 32);
                if (fq == 0) SSQ[(size_t)row * 16 + u.pn * 4 + wc] = ss; }
    }
};
struct EpiGU {
    static constexpr bool PERM = true;
    bf16_t* H; const float* SSQ;
    __device__ __forceinline__ void operator()(const f32x4 (&acc)[2][2][4][2], const pg8::Unit& u, int wr, int wc, int fr, int fq) const {
        const int hc0 = u.pn * 128 + wc * 16 + 4 * fq;
#pragma unroll
        for (int ai = 0; ai < 2; ++ai)
#pragma unroll
            for (int m = 0; m < 4; ++m) { const int row = u.pm * 256 + ai * 128 + wr * 64 + m * 16 + fr;
                const f32x4* sp = (const f32x4*)(SSQ + (size_t)row * 16); const f32x4 s0 = sp[0], s1 = sp[1], s2 = sp[2], s3 = sp[3];
                const float ss = ((s0[0] + s0[1]) + (s0[2] + s0[3])) + ((s1[0] + s1[1]) + (s1[2] + s1[3])) + ((s2[0] + s2[1]) + (s2[2] + s2[3])) + ((s3[0] + s3[1]) + (s3[2] + s3[3]));
                const float rs = rsqrtf(ss * (1.0f / DM) + EPS);
#pragma unroll
                for (int bj = 0; bj < 2; ++bj) { const f32x4 gv = acc[ai][bj][m][0] * rs, uv = acc[ai][bj][m][1] * rs; float h[4];
#pragma unroll
                    for (int e = 0; e < 4; ++e) h[e] = siluf_(gv[e]) * uv[e];
                    u32x2 w; w.x = cvt_pk(h[0], h[1]); w.y = cvt_pk(h[2], h[3]); *(u32x2*)(H + (size_t)row * FF + hc0 + bj * 64) = w; } }
    }
};
struct EpiDown {
    static constexpr bool PERM = false;
    float* O;
    __device__ __forceinline__ void operator()(const f32x4 (&acc)[2][2][4][2], const pg8::Unit& u, int wr, int wc, int fr, int fq) const {
        const int col0 = u.pn * 256 + wc * 32 + 4 * fq;
#pragma unroll
        for (int ai = 0; ai < 2; ++ai)
#pragma unroll
            for (int m = 0; m < 4; ++m) { const int row = u.pm * 256 + ai * 128 + wr * 64 + m * 16 + fr; const size_t off = (size_t)row * DM + col0;
#pragma unroll
                for (int bj = 0; bj < 2; ++bj)
#pragma unroll
                    for (int n = 0; n < 2; ++n) { float* p = O + off + bj * 128 + n * 16; const f32x4 xv = *(const f32x4*)p; *(f32x4*)p = xv + acc[ai][bj][m][n]; } }
    }
};
struct SchedCmp {
    const char* proj; const char* wt; int ncu, c;
    __device__ bool next(int i, pg8::Unit& u) const { if (c >= ncu) return false; const int L = i * ncu + c; if (L >= 32) return false;
        const int kv = L >> 4, g = (L >> 3) & 1, b = L & 7; u.pm = L; u.pn = 0;
        u.A = proj + ((size_t)b * T * LDP + (kv ? CVC : CKC) + g * 64) * 2; u.B = wt + (size_t)kv * 256 * 2048 * 2; return true; }
};
struct SchedMqk {
    const char* uc; const char* wt; int first, G, c;
    __device__ bool next(int i, pg8::Unit& u) const { if (c < first) return false; const int L = i * (G - first) + (c - first); if (L >= 512) return false;
        const int h = L >> 7, pm = L & 127; u.pm = pm; u.pn = h; u.A = uc + ((size_t)pm * 256 * 512 + h * 128) * 2; u.B = wt + (size_t)h * 256 * 128 * 2; return true; }
};

__device__ __forceinline__ void transpose_item(const float* W, int N, bf16_t* WT, int ldt, int row_off, int mode, const float* ks, float mul, LAS float* scr, int item, int lane) {
    const int nblk = N / 32, kb = item / nblk, nb = item % nblk, k0 = 64 * kb, n0 = 32 * nb;
#pragma unroll 8
    for (int i = 0; i < 32; ++i) { const int kk = 2 * i + (lane >> 5); float v = W[(size_t)(k0 + kk) * N + n0 + (lane & 31)] * mul; if (ks) v *= ks[k0 + kk]; scr[kk * 33 + (lane & 31)] = v; }
    LDS_WAIT();
    const int c = lane & 7;
#pragma unroll
    for (int j = 0; j < 4; ++j) { const int n = n0 + (lane >> 3) + 8 * j; const LAS float* s = scr + (8 * c) * 33 + (n - n0);
        u32x4 o; o.x = cvt_pk(s[0 * 33], s[1 * 33]); o.y = cvt_pk(s[2 * 33], s[3 * 33]); o.z = cvt_pk(s[4 * 33], s[5 * 33]); o.w = cvt_pk(s[6 * 33], s[7 * 33]);
        const int dst = mode == 0 ? row_off + n : ((n >> 2) * 8 + (n & 3) + (mode == 2 ? 4 : 0));
        *(u32x4*)(WT + (size_t)dst * ldt + k0 + 8 * c) = o; }
    LDS_WAIT();
}
__device__ __forceinline__ void tr64(const bf16_t* src, size_t lds_, bf16_t* dst, size_t ldd, LAS bf16_t* L, int lane, int fragmajor = 0, int tti = 0) {
#pragma unroll
    for (int i = 0; i < 8; ++i) { const int row = i * 8 + (lane >> 3), ch = lane & 7; const u32x4 w = *(const u32x4*)(src + (size_t)row * lds_ + 8 * ch);
#pragma unroll
        for (int e = 0; e < 4; ++e) { L[(8 * ch + 2 * e) * 72 + row] = (bf16_t)(w[e] & 0xffffu); L[(8 * ch + 2 * e + 1) * 72 + row] = (bf16_t)(w[e] >> 16); } }
    LDS_WAIT();
#pragma unroll
    for (int i = 0; i < 8; ++i) { const int c = i * 8 + (lane >> 3), ch = lane & 7; const u32x4 w = *(const LAS u32x4*)(L + c * 72 + 8 * ch);
        if (!fragmajor) *(u32x4*)(dst + (size_t)c * ldd + 8 * ch) = w;
        else if (fragmajor == 1) *(u32x4*)(dst + ((size_t)(((tti * 2 + (ch >> 2)) * 4 + (c >> 4)) * 64 + (ch & 3) * 16 + (c & 15))) * 8) = w;
        else *(u32x4*)(dst + ((size_t)((((tti * 8 + (fragmajor >> 8) * 4 + (c >> 4)) * 2 + (ch >> 2)) * 64) + (ch & 3) * 16 + (c & 15))) * 8) = w; }
    LDS_WAIT();
}
__device__ __forceinline__ float wave_sum(float v) {
#pragma unroll
    for (int o = 1; o < 64; o <<= 1) v += __shfl_xor(v, o);
    return v;
}

__device__ __forceinline__ float scan_sum(float v, int lane) {
#pragma unroll
    for (int d = 1; d < 64; d <<= 1) { const float t = __shfl_up(v, d); if (lane >= d) v += t; }
    return v;
}
__device__ __forceinline__ float scan_max(float v, int lane) {
#pragma unroll
    for (int d = 1; d < 64; d <<= 1) { const float t = __shfl_up(v, d); if (lane >= d) v = fmaxf(v, t); }
    return v;
}
__device__ __forceinline__ bf16x8 ld2x8(const bf16_t* p) {
    const u32x2 lo = *(const u32x2*)p, hi = *(const u32x2*)(p + 16); u32x4 w; w.x = lo.x; w.y = lo.y; w.z = hi.x; w.w = hi.y; return __builtin_bit_cast(bf16x8, w);
}

__device__ __forceinline__ void mlstm_ploc(const KParams& P, int it, int lane) {
    asm volatile("" : "+v"(lane));
    const int fr = lane & 15, fq = lane >> 4;
    const int bh = it >> 6, c = it & 63, b = bh >> 2, h = bh & 3, tc = c * 64;
    const bf16_t* proj = (const bf16_t*)(P.ws + O_PROJ);
    const size_t grow = (size_t)(b * T + tc + lane) * LDP;
    const float li = bf2f(proj[grow + CI + h]) + P.in[16][h];
    const float fz = bf2f(proj[grow + CF + h]) + P.in[17][h];
    const float lf = fminf(fz, 0.f) - log1pf(__expf(-fabsf(fz)));
    const float bc = scan_sum(lf, lane), a = li - bc, cm = scan_max(a, lane);
    { float* GT = (float*)(P.ws + O_GT) + (size_t)it * 192; GT[lane] = a; GT[64 + lane] = bc; GT[128 + lane] = cm; }
    const bf16_t* Qb = (const bf16_t*)((const char*)P.out + OUT_MQK) + (size_t)(b * T + tc) * 1024 + h * 256;
    bf16x8* PB = (bf16x8*)(P.ws + O_PB) + (size_t)it * 4 * 2 * 64;
    bf16x8* QF = (bf16x8*)(P.ws + O_XN) + (size_t)it * 4 * 4 * 64;
    const f32x4 zero4 = {0.f, 0.f, 0.f, 0.f};
    float as_[2][8];
#pragma unroll
    for (int j2 = 0; j2 < 2; ++j2)
#pragma unroll
        for (int e = 0; e < 8; ++e) as_[j2][e] = __shfl(a, 32 * j2 + 8 * fq + e);
#pragma unroll 1
    for (int lt = 0; lt < 4; ++lt) {
        const int l = 16 * lt + fr; const float cml = __shfl(cm, l);
        bf16x8 Qf[4];
#pragma unroll
        for (int j = 0; j < 4; ++j) { Qf[j] = *(const bf16x8*)(Qb + (size_t)l * 1024 + 32 * j + 8 * fq); QF[(lt * 4 + j) * 64 + lane] = ld2x8(Qb + (size_t)l * 1024 + 32 * j + 4 * fq); }
#pragma unroll
        for (int j2 = 0; j2 < 2; ++j2) { float pv[8];
#pragma unroll
            for (int hf = 0; hf < 2; ++hf) { f32x4 acc = zero4;
                if (32 * j2 <= 16 * lt + 15) {
#pragma unroll
                    for (int j = 0; j < 4; ++j) { const bf16x8 kf = *(const bf16x8*)(Qb + (size_t)(32 * j2 + 8 * (fr >> 2) + (fr & 3) + 4 * hf) * 1024 + 128 + 32 * j + 8 * fq); acc = MFMA16(kf, Qf[j], acc); } }
#pragma unroll
                for (int i = 0; i < 4; ++i) { const int sidx = 32 * j2 + 8 * fq + 4 * hf + i; pv[hf * 4 + i] = (sidx <= l) ? acc[i] * __expf(as_[j2][hf * 4 + i] - cml) : 0.f; } }
            PB[(lt * 2 + j2) * 64 + lane] = pack8(pv); }
    }
}

__device__ __forceinline__ void mlstm_unit(const KParams& P, int unit, int lane) {
    asm volatile("" : "+v"(lane));
    const int fr = lane & 15, fq = lane >> 4;
    const int bh = unit / 9, vs = unit % 9, b = bh >> 2, h = bh & 3;
    const bool den_unit = (vs == 8);
    const bf16_t* proj = (const bf16_t*)(P.ws + O_PROJ);
    const bf16_t* Qb = (const bf16_t*)((const char*)P.out + OUT_MQK) + (size_t)b * T * 1024 + h * 256;
    const bf16x8* KTF = (const bf16x8*)(P.ws + O_MKT) + (size_t)bh * 64 * 8 * 2 * 64;
    const bf16x8* VF = (const bf16x8*)(P.ws + O_MVT) + (size_t)bh * 64 * 8 * 2 * 64;
    const bf16x8* QFb = (const bf16x8*)(P.ws + O_XN) + (size_t)bh * 64 * 4 * 4 * 64;
    float* NUM = P.out;
    float* DEN = (float*)(P.ws + O_DEN) + (size_t)bh * T;
    const float bi = P.in[16][h], bfv = P.in[17][h];
    const f32x4 zero4 = {0.f, 0.f, 0.f, 0.f};
    f32x4 Ct[8];
#pragma unroll
    for (int i = 0; i < 8; ++i) Ct[i] = zero4;
    float m_prev = 0.f;
    __builtin_amdgcn_s_setprio(3);
    const float* GTb = (const float*)(P.ws + O_GT) + (size_t)bh * 64 * 192;
    float a_n = GTb[lane], bc_n = GTb[64 + lane], cm_n = GTb[128 + lane];
    const bf16x8* PBb = (const bf16x8*)(P.ws + O_PB) + (size_t)bh * 64 * 4 * 2 * 64;
#pragma unroll 1
    for (int c = 0; c < 64; ++c) {
        const int tc = c * 64;
        bf16x8 pbv[8], Qa[4][4];
#pragma unroll
        for (int i = 0; i < 8; ++i) pbv[i] = PBb[(size_t)(c * 8 + i) * 64 + lane];
#pragma unroll
        for (int lt = 0; lt < 4; ++lt)
#pragma unroll
            for (int j = 0; j < 4; ++j) Qa[lt][j] = QFb[(size_t)((c * 4 + lt) * 4 + j) * 64 + lane];
        const float a = a_n, bc = bc_n, cm = cm_n;
        { const int cn = (c < 63) ? c + 1 : c; const float* gp = GTb + (size_t)cn * 192; a_n = gp[lane]; bc_n = gp[64 + lane]; cm_n = gp[128 + lane]; }
        const float gg = __shfl(bc, 63);
        const float mw = gg + __shfl(cm, 63);
        const float m_new = fmaxf(gg + m_prev, mw);
        const float decay = __expf(gg + m_prev - m_new);
        const float wv = __expf(gg + a - m_new);
        const float mm = fmaxf(m_prev, cm);
        const float inter = __expf(m_prev - mm);
        const float eneg = __expf(-(bc + mm));
        bf16x8 Cb[4];
#pragma unroll
        for (int j = 0; j < 4; ++j) { float f[8];
#pragma unroll
            for (int i = 0; i < 4; ++i) { f[i] = Ct[2 * j][i]; f[4 + i] = Ct[2 * j + 1][i]; }
            Cb[j] = pack8(f); }
        bf16x8 Vf[2];
#pragma unroll
        for (int j2 = 0; j2 < 2; ++j2) {
            if (den_unit) { const unsigned o = (fr == 0) ? 0x3F803F80u : 0u; u32x4 w = {o, o, o, o}; Vf[j2] = __builtin_bit_cast(bf16x8, w); }
            else Vf[j2] = VF[(size_t)((c * 8 + vs) * 2 + j2) * 64 + lane];
        }
#define ML_BODY(lt_) { const int l = 16 * (lt_) + fr; \
            const float mml = __shfl(mm, l), il = __shfl(inter, l), en = __shfl(eneg, l); \
            const float fl = __expf(__shfl(cm, l) - mml); \
            f32x4 a1 = zero4, a2 = zero4; \
            _Pragma("unroll") for (int j = 0; j < 4; ++j) a1 = MFMA16(Cb[j], Qa[lt_][j], a1); \
            _Pragma("unroll") for (int j2 = 0; j2 < 2; ++j2) a2 = MFMA16(Vf[j2], pbv[(lt_) * 2 + j2], a2); \
            const f32x4 nv = a1 * il + a2 * fl; \
            if (!den_unit) *(f32x4*)(NUM + (size_t)(b * T + tc + l) * 512 + h * 128 + vs * 16 + 4 * fq) = nv; \
            else if (fq == 0) DEN[tc + l] = fmaxf(fabsf(nv[0]), en); }
        ML_BODY(0) ML_BODY(1)
        asm volatile("" ::: "memory");
        bf16x8 ktf[8][2];
#pragma unroll
        for (int kt = 0; kt < 8; ++kt)
#pragma unroll
            for (int j2 = 0; j2 < 2; ++j2) ktf[kt][j2] = KTF[(size_t)((c * 8 + kt) * 2 + j2) * 64 + lane];
        ML_BODY(2) ML_BODY(3)
#undef ML_BODY
        bf16x8 wV[2];
#pragma unroll
        for (int j2 = 0; j2 < 2; ++j2) { float f[8];
            if (den_unit) {
#pragma unroll
                for (int e = 0; e < 8; ++e) { const float w = __shfl(wv, 32 * j2 + 8 * fq + e); f[e] = (fr == 0) ? w : 0.f; }
            } else { unpack8(__builtin_bit_cast(u32x4, Vf[j2]), f);
#pragma unroll
                for (int e = 0; e < 8; ++e) f[e] *= __shfl(wv, 32 * j2 + 8 * fq + e); }
            wV[j2] = pack8(f); }
#pragma unroll
        for (int kt = 0; kt < 8; ++kt) { f32x4 acc = Ct[kt] * decay;
#pragma unroll
            for (int j2 = 0; j2 < 2; ++j2) acc = MFMA16(ktf[kt][j2], wV[j2], acc);
            Ct[kt] = acc; }
        m_prev = m_new;
    }
    __builtin_amdgcn_s_setprio(0);
}

template <int MODE>
__device__ __forceinline__ void nsa_branch(const bf16_t* Kb, const bf16_t* Vt, int ldv, int kb_lo, int kb_hi, const bf16x8 (&qf)[4][2], const float (&slope2)[4],
                                           int t, unsigned selLo, unsigned selHi, float (&l)[4], f32x4 (&o)[4][4], LAS float* impL, int fr, int fq, const bool needimp = true) {
    const f32x4 zero4 = {0.f, 0.f, 0.f, 0.f};
    constexpr float MREF = 16.0f;
#pragma unroll 1
    for (int kb = kb_lo; kb < kb_hi; ++kb) {
        bool selb = true;
        if (MODE == 2) { const int n = kb >> 1; selb = (n < 32) ? (((selLo >> n) & 1u) != 0u) : (((selHi >> (n - 32)) & 1u) != 0u); if (__ballot(selb) == 0ull) continue; }
        bf16x8 kf[2][2];
#pragma unroll
        for (int tl = 0; tl < 2; ++tl) {
            const bf16x8* kp = (const bf16x8*)Kb + (size_t)((kb * 2 + tl) * 2) * 64 + fq * 16 + fr; kf[tl][0] = kp[0]; kf[tl][1] = kp[64]; }
        bf16x8 vf[4];
        if (MODE != 0) {
#pragma unroll
            for (int dt = 0; dt < 4; ++dt) {
                vf[dt] = ((const bf16x8*)Vt)[(size_t)(kb * 4 + dt) * 64 + fq * 16 + fr]; }
        }
        bool valid[2][4]; float dist[2][4];
#pragma unroll
        for (int tl = 0; tl < 2; ++tl)
#pragma unroll
            for (int i = 0; i < 4; ++i) { const int key = kb * 32 + fq * 8 + tl * 4 + i;
                if (MODE <= 1) { const int pos = key * 16 + 31; valid[tl][i] = pos <= t; dist[tl][i] = (float)(t - pos); }
                else if (MODE == 2) { valid[tl][i] = selb && (key <= t); dist[tl][i] = (float)(t - key); }
                else { valid[tl][i] = (key <= t) && (t - key < 512); dist[tl][i] = (float)(t - key); } }
        float imps[2][4];
#pragma unroll
        for (int tl = 0; tl < 2; ++tl)
#pragma unroll
            for (int i = 0; i < 4; ++i) imps[tl][i] = 0.f;
#pragma unroll
        for (int r = 0; r < 4; ++r) {
            float p[8]; float ps = 0.f;
#pragma unroll
            for (int tl = 0; tl < 2; ++tl) { f32x4 sv = MFMA16(kf[tl][0], qf[r][0], zero4); sv = MFMA16(kf[tl][1], qf[r][1], sv);
#pragma unroll
                for (int i = 0; i < 4; ++i) {
                    float pe = __builtin_amdgcn_exp2f((sv[i] - MREF) - slope2[r] * dist[tl][i]);
                    pe = valid[tl][i] ? pe : 0.f;
                    if (MODE == 1) { pe *= l[r]; imps[tl][i] += pe; } else ps += pe;
                    p[tl * 4 + i] = pe; } }
            if (MODE != 1) l[r] += ps;
            if (MODE != 0) { const bf16x8 pb = pack8(p);
#pragma unroll
                for (int dt = 0; dt < 4; ++dt) o[dt][r] = MFMA16(vf[dt], pb, o[dt][r]); }
        }
        if (MODE == 1 && needimp) {
#pragma unroll
            for (int tl = 0; tl < 2; ++tl) { const int n = kb * 8 + fq * 2 + tl; impL[fr * 64 + n] += (imps[tl][0] + imps[tl][1]) + (imps[tl][2] + imps[tl][3]); }
            LDS_WAIT();
#pragma unroll
            for (int tl = 0; tl < 2; ++tl) { const int n = kb * 8 + fq * 2 + tl + 1; if (n < 64) impL[fr * 64 + n] += imps[tl][3]; LDS_WAIT(); }
        }
    }
}

__device__ __forceinline__ void nsa_item(const KParams& P, LAS float* impL, int item, int lane) {
    asm volatile("" : "+v"(lane));
    const int fr = lane & 15, fq = lane >> 4;
    const int bg = item & 15, tt = 255 - (item >> 4), b = bg >> 1, g = bg & 1, t0 = tt * 16, t = t0 + fr;
    const bf16_t* proj = (const bf16_t*)(P.ws + O_PROJ);
    const size_t rowq = (size_t)(b * T + t) * LDP;
    const f32x4 zero4 = {0.f, 0.f, 0.f, 0.f};
    const float* qg = P.in[3];
    bf16x8 qf[4][2]; float slope2[4];
#pragma unroll
    for (int r = 0; r < 4; ++r) {
        const int hd = g * 4 + r;
        const bf16_t* qp = proj + rowq + CQ + hd * 64 + fq * 8;
        float f0[8], f1[8]; unpack8(*(const u32x4*)qp, f0); unpack8(*(const u32x4*)(qp + 32), f1);
        float ss = 0.f;
#pragma unroll
        for (int e = 0; e < 8; ++e) ss += f0[e] * f0[e] + f1[e] * f1[e];
        ss += __shfl_xor(ss, 16); ss += __shfl_xor(ss, 32);
        const float rs = rsqrtf(ss * (1.0f / 64.0f) + EPS) * (0.125f * LOG2E);
#pragma unroll
        for (int e = 0; e < 8; ++e) { f0[e] *= rs * qg[fq * 8 + e]; f1[e] *= rs * qg[32 + fq * 8 + e]; }
        qf[r][0] = pack8(f0); qf[r][1] = pack8(f1);
        slope2[r] = __builtin_amdgcn_exp2f(-(float)(hd + 1)) * LOG2E;
    }
    u32x2 acc[4][4];
#pragma unroll
    for (int dt = 0; dt < 4; ++dt)
#pragma unroll
        for (int r = 0; r < 4; ++r) acc[dt][r] = (u32x2){0u, 0u};
    float l[4]; f32x4 o[4][4];
    if (t0 + 15 >= 1024) {
#pragma unroll
        for (int i = 0; i < 16; ++i) impL[i * 64 + lane] = 0.f;
    }
    LDS_WAIT();
    if (t0 >= 16) {
        const bf16_t* KCp = (const bf16_t*)(P.ws + O_KC) + (size_t)bg * 256 * 64;
        const bf16_t* VCp = (const bf16_t*)(P.ws + O_VCT) + (size_t)bg * 64 * 256;
        const int kb_hi = (t0 / 16 + 31) / 32;
#pragma unroll
        for (int r = 0; r < 4; ++r) { l[r] = 0.f;
#pragma unroll
            for (int dt = 0; dt < 4; ++dt) o[dt][r] = zero4; }
        nsa_branch<0>(KCp, VCp, 256, 0, kb_hi, qf, slope2, t, 0u, 0u, l, o, impL, fr, fq);
#pragma unroll
        for (int r = 0; r < 4; ++r) { l[r] += __shfl_xor(l[r], 16); l[r] += __shfl_xor(l[r], 32); l[r] = (l[r] > 0.f) ? 1.0f / l[r] : 0.f; }
        nsa_branch<1>(KCp, VCp, 256, 0, kb_hi, qf, slope2, t, 0u, 0u, l, o, impL, fr, fq, t0 + 15 >= 1024);
#pragma unroll
        for (int r = 0; r < 4; ++r) { const float gt = sigmoidf_(bf2f(proj[rowq + CG + (g * 4 + r) * 3 + 0]));
#pragma unroll
            for (int dt = 0; dt < 4; ++dt) { u32x2 w; w.x = cvt_pk(o[dt][r][0] * gt, o[dt][r][1] * gt); w.y = cvt_pk(o[dt][r][2] * gt, o[dt][r][3] * gt); acc[dt][r] = w; } }
    }
    LDS_WAIT();
    unsigned selLo = 0u, selHi = 0u;
    if (t0 + 15 < 1024) selLo = (2u << (t >> 6)) - 1u;
    else
#pragma unroll 1
    for (int tau = 0; tau < 16; ++tau) {
        const int tq = t0 + tau; float v = impL[tau * 64 + lane];
        if (lane == (tq >> 6) || lane == 0) v = 1e9f; else if (64 * lane > tq) v = -1e9f;
        int rank = 0;
#pragma unroll 8
        for (int mi = 0; mi < 64; ++mi) { const float vm = __uint_as_float(__builtin_amdgcn_readlane(__float_as_uint(v), mi)); rank += ((vm > v) || (vm == v && mi < lane)) ? 1 : 0; }
        const unsigned long long msk = __ballot(rank < 16);
        if (fr == tau) { selLo = (unsigned)msk; selHi = (unsigned)(msk >> 32); }
    }
    {
        const bf16_t* Ks = (const bf16_t*)(P.ws + O_KSN) + (size_t)bg * T * 64;
        const bf16_t* Vs = (const bf16_t*)(P.ws + O_VST) + (size_t)bg * 64 * T;
#pragma unroll
        for (int r = 0; r < 4; ++r) { l[r] = 0.f;
#pragma unroll
            for (int dt = 0; dt < 4; ++dt) o[dt][r] = zero4; }
        nsa_branch<2>(Ks, Vs, T, 0, (t0 / 64 + 1) * 2, qf, slope2, t, selLo, selHi, l, o, impL, fr, fq);
#pragma unroll
        for (int r = 0; r < 4; ++r) { l[r] += __shfl_xor(l[r], 16); l[r] += __shfl_xor(l[r], 32);
            const float gt = sigmoidf_(bf2f(proj[rowq + CG + (g * 4 + r) * 3 + 1])); const float sc = (l[r] > 0.f) ? gt / l[r] : 0.f;
#pragma unroll
            for (int dt = 0; dt < 4; ++dt) { const u32x2 w = acc[dt][r];
                const f32x4 ov = (f32x4){__uint_as_float(w.x << 16), __uint_as_float(w.x & 0xffff0000u), __uint_as_float(w.y << 16), __uint_as_float(w.y & 0xffff0000u)} + o[dt][r] * sc;
                u32x2 w2; w2.x = cvt_pk(ov[0], ov[1]); w2.y = cvt_pk(ov[2], ov[3]); acc[dt][r] = w2; } }
    }
    {
        const bf16_t* Kw = (const bf16_t*)(P.ws + O_KWN) + (size_t)bg * T * 64;
        const bf16_t* Vw = (const bf16_t*)(P.ws + O_VWT) + (size_t)bg * 64 * T;
#pragma unroll
        for (int r = 0; r < 4; ++r) { l[r] = 0.f;
#pragma unroll
            for (int dt = 0; dt < 4; ++dt) o[dt][r] = zero4; }
        const int kb_lo = (t0 > 511) ? (t0 - 511) / 32 : 0;
        nsa_branch<3>(Kw, Vw, T, kb_lo, t0 / 32 + 1, qf, slope2, t, 0u, 0u, l, o, impL, fr, fq);
        bf16_t* Yp = (bf16_t*)(P.ws + O_Y) + (size_t)(b * T + t) * DM + g * 256;
#pragma unroll
        for (int r = 0; r < 4; ++r) { l[r] += __shfl_xor(l[r], 16); l[r] += __shfl_xor(l[r], 32);
            const float gt = sigmoidf_(bf2f(proj[rowq + CG + (g * 4 + r) * 3 + 2])); const float sc = (l[r] > 0.f) ? gt / l[r] : 0.f;
#pragma unroll
            for (int dt = 0; dt < 4; ++dt) { const u32x2 w = acc[dt][r];
                const f32x4 ov = (f32x4){__uint_as_float(w.x << 16), __uint_as_float(w.x & 0xffff0000u), __uint_as_float(w.y << 16), __uint_as_float(w.y & 0xffff0000u)} + o[dt][r] * sc;
                u32x2 w2; w2.x = cvt_pk(ov[0], ov[1]); w2.y = cvt_pk(ov[2], ov[3]); *(u32x2*)(Yp + r * 64 + dt * 16 + fq * 4) = w2; } }
    }
}

#ifndef PH_MASK
#define PH_MASK 1023
#endif
__global__ void __launch_bounds__(512) fwd_kernel(KParams P) {
    extern __shared__ __attribute__((aligned(16))) unsigned char lds_raw[];
    LAS unsigned char* lds = (LAS unsigned char*)lds_raw;
    cg::grid_group grid = cg::this_grid();
    const int G = gridDim.x, bx = blockIdx.x, NGW = G * 8;
    unsigned char* ws = P.ws;
#define GRID_SYNC() do { __syncthreads(); grid.sync(); } while (0)
#define FRESH_IDS int tid = threadIdx.x; asm volatile("" : "+v"(tid)); const int lane = tid & 63, wave = __builtin_amdgcn_readfirstlane(tid >> 6), gw = bx * 8 + wave; LAS float* scr = (LAS float*)(lds + wave * 16384); (void)lane; (void)gw; (void)scr;
#define WTIN ((bf16_t*)(ws + O_WTIN))
#define WTOUT ((bf16_t*)(ws + O_WTOUT))
#define WTGU ((bf16_t*)(ws + O_WTGU))
#define WTDN ((bf16_t*)(ws + O_WTDN))
#define WTC1 ((bf16_t*)(ws + O_WTC1))
#define WTC2 ((bf16_t*)(ws + O_WTC2))
#define WTMQK ((bf16_t*)(ws + O_WTMQK))
#define POSP ((float*)(ws + O_POSP))
#define POSB ((float*)(ws + O_POSB))
#define SSQ ((float*)(ws + O_SSQ))
#define DEN ((float*)(ws + O_DEN))
#define KC ((bf16_t*)(ws + O_KC))
#define VCT ((bf16_t*)(ws + O_VCT))
#define HC ((bf16_t*)(ws + O_HC))
#define XN ((bf16_t*)(ws + O_XN))
#define PROJ ((bf16_t*)(ws + O_PROJ))
#define UC ((bf16_t*)(ws + O_UC))
#define KSN ((bf16_t*)(ws + O_KSN))
#define KWN ((bf16_t*)(ws + O_KWN))
#define VST ((bf16_t*)(ws + O_VST))
#define VWT ((bf16_t*)(ws + O_VWT))
#define MVT ((bf16_t*)(ws + O_MVT))
#define MKT ((bf16_t*)(ws + O_MKT))
#define YB ((bf16_t*)(ws + O_Y))
#define MQK ((bf16_t*)((char*)P.out + OUT_MQK))

#if (PH_MASK >> 0) & 1
    {
        FRESH_IDS
        constexpr int I_IN = 16 * 89, I_OUT = 16 * 32, I_G = 16 * 88, I_D = 44 * 32, I_C1 = 32 * 8, I_C2 = 4 * 2, I_MQ = 4 * 8;
        constexpr int NIT = I_IN + I_OUT + 2 * I_G + I_D + 2 * I_C1 + 2 * I_C2 + 2 * I_MQ;
        constexpr int NIT0 = I_IN + 2 * I_C1 + 2 * I_C2 + 2 * I_MQ;
        for (int it = gw; it < NIT0; it += NGW) {
            int r = it;
            if (r < I_IN) { transpose_item(P.in[2], INW, WTIN, DM, 0, 0, nullptr, 1.f, scr, r, lane); continue; } r -= I_IN;
            if (r < I_C1) { transpose_item(P.in[8], 256, WTC1, 2048, 0, 0, nullptr, 1.f, scr, r, lane); continue; } r -= I_C1;
            if (r < I_C1) { transpose_item(P.in[10], 256, WTC1 + 256 * 2048, 2048, 0, 0, nullptr, 1.f, scr, r, lane); continue; } r -= I_C1;
            if (r < I_C2) { transpose_item(P.in[9], 64, WTC2, 256, 0, 0, nullptr, 1.f, scr, r, lane); continue; } r -= I_C2;
            if (r < I_C2) { transpose_item(P.in[11], 64, WTC2 + 64 * 256, 256, 0, 0, nullptr, 1.f, scr, r, lane); continue; } r -= I_C2;
            if (r < I_MQ) { const int h = r >> 3; transpose_item(P.in[14] + h * 16384, 128, WTMQK, 128, h * 256, 0, nullptr, 1.f, scr, r & 7, lane); continue; } r -= I_MQ;
            { const int h = r >> 3; transpose_item(P.in[15] + h * 16384, 128, WTMQK, 128, h * 256 + 128, 0, nullptr, 0.08838834764831845f, scr, r & 7, lane); }
        }
        for (int i = bx * 512 + tid; i < (LDP - INW) * DM / 8; i += G * 512) ((u32x4*)(WTIN + (size_t)INW * DM))[i] = (u32x4){0u, 0u, 0u, 0u};
        const float* x = P.in[0]; const float* g1 = P.in[1];
        for (int mrow = gw; mrow < M; mrow += NGW) {
            const f32x4* xr = (const f32x4*)(x + (size_t)mrow * DM) + lane; f32x4 v[4]; float s = 0.f;
#pragma unroll
            for (int j = 0; j < 4; ++j) { v[j] = xr[64 * j]; s += (v[j][0] * v[j][0] + v[j][1] * v[j][1]) + (v[j][2] * v[j][2] + v[j][3] * v[j][3]); }
            const float rs = rsqrtf(wave_sum(s) * (1.0f / DM) + EPS);
            u32x2* o8 = (u32x2*)(XN + (size_t)mrow * DM) + lane;
#pragma unroll
            for (int j = 0; j < 4; ++j) { const f32x4 gv = ((const f32x4*)g1)[lane + 64 * j]; u32x2 w; w.x = cvt_pk(v[j][0] * rs * gv[0], v[j][1] * rs * gv[1]); w.y = cvt_pk(v[j][2] * rs * gv[2], v[j][3] * rs * gv[3]); o8[64 * j] = w; }
        }
        for (int kb = bx; kb < 64; kb += G) { const int kv = tid >> 8, n = tid & 255; const float* w1 = P.in[kv ? 10 : 8]; const float* pos = P.in[7]; float acc = 0.f;
#pragma unroll 8
            for (int kk = 32 * kb; kk < 32 * kb + 32; ++kk) acc += pos[kk] * w1[(size_t)kk * 256 + n];
            POSP[kb * 512 + tid] = acc; }
    }
#endif
    GRID_SYNC();
#if (PH_MASK >> 1) & 1
    {
        FRESH_IDS
        pg8::Cfg g{DM, DM, DM, 128, 128}; pg8::Sched2D S; S.init(XN, WTIN, (size_t)256 * DM * 2, (size_t)256 * DM * 2, M / 256, LDP / 256, G, bx);
        EpiBf16<0> E{PROJ, LDP, nullptr};
        pg8::gemm_phase(lds, g, S, E);
    }
#endif
    GRID_SYNC();
#if (PH_MASK >> 3) & 1
    {
        FRESH_IDS
        const int ncmp = (G >= 64) ? 32 : G, first = (G >= 64) ? 32 : 0;
        float* POSBp = (float*)(ws + O_SSQ) + (size_t)bx * 512;
        if (bx < ncmp) { float acc = 0.f; for (int kb = 0; kb < 64; ++kb) acc += POSP[kb * 512 + tid]; POSBp[tid] = acc; }
        if (bx >= first) {
            const float* cw = P.in[12]; const float* cb = P.in[13];
            SchedMqk S0{(const char*)UC, (const char*)WTMQK, first, G, bx}; pg8::Unit uu;
            for (int i = 0; S0.next(i, uu); ++i) {
                const int c4 = uu.pn * 128 + (tid & 31) * 4, rg = uu.pm * 256 + (tid >> 5) * 16;
                const f32x4 w0 = *(const f32x4*)(cw + c4), w1 = *(const f32x4*)(cw + 512 + c4), w2 = *(const f32x4*)(cw + 1024 + c4), w3 = *(const f32x4*)(cw + 1536 + c4), bb = *(const f32x4*)(cb + c4);
                const f32x4 z4 = {0.f, 0.f, 0.f, 0.f};
                f32x4 u3 = z4, u2 = z4, u1 = z4;
                if ((rg & (T - 1)) != 0) {
                    const u32x2 a3 = *(const u32x2*)(PROJ + (size_t)(rg - 3) * LDP + CU + c4), a2 = *(const u32x2*)(PROJ + (size_t)(rg - 2) * LDP + CU + c4), a1 = *(const u32x2*)(PROJ + (size_t)(rg - 1) * LDP + CU + c4);
                    u3 = (f32x4){__uint_as_float(a3.x << 16), __uint_as_float(a3.x & 0xffff0000u), __uint_as_float(a3.y << 16), __uint_as_float(a3.y & 0xffff0000u)};
                    u2 = (f32x4){__uint_as_float(a2.x << 16), __uint_as_float(a2.x & 0xffff0000u), __uint_as_float(a2.y << 16), __uint_as_float(a2.y & 0xffff0000u)};
                    u1 = (f32x4){__uint_as_float(a1.x << 16), __uint_as_float(a1.x & 0xffff0000u), __uint_as_float(a1.y << 16), __uint_as_float(a1.y & 0xffff0000u)}; }
#pragma unroll 4
                for (int r = 0; r < 16; ++r) { const u32x2 a0 = *(const u32x2*)(PROJ + (size_t)(rg + r) * LDP + CU + c4);
                    const f32x4 u0 = {__uint_as_float(a0.x << 16), __uint_as_float(a0.x & 0xffff0000u), __uint_as_float(a0.y << 16), __uint_as_float(a0.y & 0xffff0000u)};
                    const f32x4 yv = w0 * u3 + w1 * u2 + w2 * u1 + w3 * u0 + bb;
                    u32x2 o; o.x = cvt_pk(siluf_(yv[0]), siluf_(yv[1])); o.y = cvt_pk(siluf_(yv[2]), siluf_(yv[3])); *(u32x2*)(UC + (size_t)(rg + r) * 512 + c4) = o;
                    u3 = u2; u2 = u1; u1 = u0; }
            }
        }
        asm volatile("s_waitcnt vmcnt(0)" ::: "memory");
        __syncthreads();
        { pg8::Cfg g{2048, 16 * LDP, 2048, LDP * 2, 128}; SchedCmp S{(const char*)PROJ, (const char*)WTC1, ncmp, bx}; EpiBf16<1> E{HC, 256, POSBp}; pg8::gemm_phase(lds, g, S, E); }
        { pg8::Cfg g{128, 512, 128, 128, 128}; SchedMqk S{(const char*)UC, (const char*)WTMQK, first, G, bx}; EpiBf16<0> E{MQK, 1024, nullptr}; pg8::gemm_phase(lds, g, S, E); }
        if (bx >= first) {
            __syncthreads();
            const int gw2 = (bx - first) * 8 + wave, NGW2 = (G - first) * 8;
        for (int mrow = gw2; mrow < M; mrow += NGW2) {
            const int which = lane >> 4, c4 = (lane & 15) * 4, col = (which < 2 ? CKS : CKW) + (which & 1) * 64 + c4;
            const u32x2 w = *(const u32x2*)(PROJ + (size_t)mrow * LDP + col);
            float f[4] = {__uint_as_float(w.x << 16), __uint_as_float(w.x & 0xffff0000u), __uint_as_float(w.y << 16), __uint_as_float(w.y & 0xffff0000u)};
            float ss = (f[0] * f[0] + f[1] * f[1]) + (f[2] * f[2] + f[3] * f[3]);
            ss += __shfl_xor(ss, 1); ss += __shfl_xor(ss, 2); ss += __shfl_xor(ss, 4); ss += __shfl_xor(ss, 8);
            const float rs = rsqrtf(ss * (1.0f / 64.0f) + EPS); const float* gn = P.in[which < 2 ? 5 : 6] + c4;
            const int b = mrow / T, t = mrow % T;
            u32x2 ov; ov.x = cvt_pk(f[0] * rs * gn[0], f[1] * rs * gn[1]); ov.y = cvt_pk(f[2] * rs * gn[2], f[3] * rs * gn[3]);
            { const int kb = t >> 5, wi = t & 31, tl = (wi >> 2) & 1, frr = ((wi >> 3) << 2) | (wi & 3), ks = c4 >> 5, fqq = (c4 & 31) >> 3, e = c4 & 7;
              *(u32x2*)((which < 2 ? KSN : KWN) + (size_t)(b * 2 + (which & 1)) * T * 64 + ((size_t)(((kb * 2 + tl) * 2 + ks) * 64 + fqq * 16 + frr)) * 8 + e) = ov; }
        }
        for (int it = gw2; it < NB * 64 * 12; it += NGW2) {
            const int grp = it % 12, rest = it / 12, tti = rest & 63, b = rest >> 6;
            int col; bf16_t* dst;
            if (grp < 2) { col = CVS + grp * 64; dst = VST + (size_t)(b * 2 + grp) * 64 * T; }
            else if (grp < 4) { col = CVW + (grp - 2) * 64; dst = VWT + (size_t)(b * 2 + grp - 2) * 64 * T; }
            else { col = CVM + (grp - 4) * 64; dst = MVT + ((size_t)b * 512 + (grp - 4) * 64) * T; }
            if (grp < 4) tr64(PROJ + (size_t)(b * T + tti * 64) * LDP + col, LDP, dst, T, (LAS bf16_t*)scr, lane, 1, tti);
            else tr64(PROJ + (size_t)(b * T + tti * 64) * LDP + col, LDP, MVT + (size_t)(b * 4 + ((grp - 4) >> 1)) * 128 * T, T, (LAS bf16_t*)scr, lane, 2 | (((grp - 4) & 1) << 8), tti);
        }
        }
        asm volatile("s_waitcnt vmcnt(0)" ::: "memory");
        __syncthreads();
        {
        const f32x4 zero4 = {0.f, 0.f, 0.f, 0.f};
        const int fr = lane & 15, fq = lane >> 4;
        if (bx < ncmp) for (int L_ = bx; L_ < 32; L_ += ncmp) for (int rt_ = wave; rt_ < 16; rt_ += 8) { const int it = L_ * 16 + rt_;
            const int L = it >> 4, rt = it & 15, kv = L >> 4, bgi = (L & 7) * 2 + ((L >> 3) & 1);
            const bf16_t* Hp = HC + ((size_t)L * 256 + rt * 16 + fr) * 256 + fq * 8;
            const bf16_t* Wp = WTC2 + (size_t)kv * 64 * 256 + (size_t)fr * 256 + fq * 8;
            f32x4 acc[4] = {zero4, zero4, zero4, zero4};
#pragma unroll
            for (int ks = 0; ks < 8; ++ks) { const bf16x8 hf = *(const bf16x8*)(Hp + 32 * ks);
#pragma unroll
                for (int nt = 0; nt < 4; ++nt) { const bf16x8 wf = *(const bf16x8*)(Wp + (size_t)nt * 16 * 256 + 32 * ks);
                    acc[nt] = (kv == 0) ? MFMA16(wf, hf, acc[nt]) : MFMA16(hf, wf, acc[nt]); } }
            if (kv == 0) {
                float ss = 0.f;
#pragma unroll
                for (int nt = 0; nt < 4; ++nt) ss += (acc[nt][0] * acc[nt][0] + acc[nt][1] * acc[nt][1]) + (acc[nt][2] * acc[nt][2] + acc[nt][3] * acc[nt][3]);
                ss += __shfl_xor(ss, 16); ss += __shfl_xor(ss, 32);
                float rs = rsqrtf(ss * (1.0f / 64.0f) + EPS); const int j = rt * 16 + fr; if (j == 255) rs = 0.f;
                const float* gn = P.in[4];
#pragma unroll
                for (int nt = 0; nt < 4; ++nt) { const int n = 16 * nt + 4 * fq; u32x2 w; w.x = cvt_pk(acc[nt][0] * rs * gn[n], acc[nt][1] * rs * gn[n + 1]); w.y = cvt_pk(acc[nt][2] * rs * gn[n + 2], acc[nt][3] * rs * gn[n + 3]);
                    { const int kb = j >> 5, wi = j & 31, tl = (wi >> 2) & 1, frr = ((wi >> 3) << 2) | (wi & 3), ks = n >> 5, fqq = (n & 31) >> 3, e = n & 7;
                      *(u32x2*)(KC + (size_t)bgi * 256 * 64 + ((size_t)(((kb * 2 + tl) * 2 + ks) * 64 + fqq * 16 + frr)) * 8 + e) = w; } }
            } else {
#pragma unroll
                for (int nt = 0; nt < 4; ++nt) { const int j0 = rt * 16 + 4 * fq; const float v3 = (j0 + 3 == 255) ? 0.f : acc[nt][3];
                    u32x2 w; w.x = cvt_pk(acc[nt][0], acc[nt][1]); w.y = cvt_pk(acc[nt][2], v3);
                    { const int kb = j0 >> 5, fqq = (j0 & 31) >> 3, e = j0 & 7;
                      *(u32x2*)(VCT + (size_t)bgi * 64 * 256 + ((size_t)((kb * 4 + nt) * 64 + fqq * 16 + fr)) * 8 + e) = w; } }
            }
        }
        if (bx >= first) {
            SchedMqk S1{(const char*)UC, (const char*)WTMQK, first, G, bx}; pg8::Unit uu;
            for (int i = 0; S1.next(i, uu); ++i) {
                const int h = uu.pn, b = uu.pm >> 4, tti0 = (uu.pm & 15) * 4;
                { const int tti = tti0 + (wave >> 1), half = wave & 1;
                  tr64(MQK + (size_t)(b * T + tti * 64) * 1024 + h * 256 + 128 + half * 64, 1024, MKT + (size_t)(b * 4 + h) * 128 * T, T, (LAS bf16_t*)scr, lane, 2 | (half << 8), tti); }
#pragma unroll 1
                for (int j = 0; j < 4; ++j) if (((i * 4 + j) & 7) == wave) mlstm_ploc(P, (b * 4 + h) * 64 + tti0 + j, lane);
            }
        }
        }
    }
#endif
    GRID_SYNC();
#if (PH_MASK >> 5) & 1
    {
        FRESH_IDS
        unsigned* ctr = (unsigned*)(ws + O_CTL);
        for (;;) {
            unsigned it = 0; if (lane == 0) it = atomicAdd(ctr, 1u);
            it = __builtin_amdgcn_readfirstlane(it);
            if (it >= (unsigned)N_ML) break;
            mlstm_unit(P, (int)it, lane);
        }
        for (int dx = 0; dx < 8; ++dx) {
            const int x = (bx + dx) & 7; unsigned* q = ctr + 32 * (1 + x);
            for (;;) {
                unsigned it = 0; if (lane == 0) it = atomicAdd(q, 1u);
                it = __builtin_amdgcn_readfirstlane(it);
                if (it >= 512u) break;
                nsa_item(P, scr, (int)(((it & 255u) << 4) | (2u * x + (it >> 8))), lane);
            }
        }
        {
            constexpr int I_OUT = 16 * 32, I_G = 16 * 88, I_D = 44 * 32, NITF = I_OUT + 2 * I_G + I_D;
            unsigned* qf_ = ctr + 32 * 10;
            for (;;) {
                unsigned it = 0; if (lane == 0) it = atomicAdd(qf_, 1u);
                it = __builtin_amdgcn_readfirstlane(it);
                if (it >= (unsigned)NITF) break;
                int r = (int)it;
                if (r < I_OUT) { transpose_item(P.in[20], DM, WTOUT, DM, 0, 0, nullptr, 1.f, scr, r, lane); continue; } r -= I_OUT;
                if (r < I_G) { transpose_item(P.in[22], FF, WTGU, DM, 0, 1, P.in[21], 1.f, scr, r, lane); continue; } r -= I_G;
                if (r < I_G) { transpose_item(P.in[23], FF, WTGU, DM, 0, 2, P.in[21], 1.f, scr, r, lane); continue; } r -= I_G;
                transpose_item(P.in[24], DM, WTDN, FF, 0, 0, nullptr, 1.f, scr, r, lane);
            }
        }
    }
#endif
    GRID_SYNC();
#if (PH_MASK >> 6) & 1
    {
        FRESH_IDS
        const float* NUM = P.out; const float* ng = P.in[18]; const float* sk = P.in[19];
        for (int idx = gw * 4 + (lane >> 4); idx < M * 4; idx += NGW * 4) {
            const int mrow = idx >> 2, h = idx & 3, b = mrow / T, t = mrow % T, c = h * 128 + 8 * (lane & 15);
            const f32x4 n0 = *(const f32x4*)(NUM + (size_t)mrow * 512 + c), n1 = *(const f32x4*)(NUM + (size_t)mrow * 512 + c + 4);
            const float rd = 1.0f / DEN[(size_t)(b * 4 + h) * T + t];
            float og[8], uf[8]; unpack8(*(const u32x4*)(PROJ + (size_t)mrow * LDP + CO + c), og); unpack8(*(const u32x4*)(UC + (size_t)mrow * 512 + c), uf);
            float hv[8]; float ss = 0.f;
#pragma unroll
            for (int e = 0; e < 4; ++e) { hv[e] = n0[e] * rd * sigmoidf_(og[e]); hv[4 + e] = n1[e] * rd * sigmoidf_(og[4 + e]); }
#pragma unroll
            for (int e = 0; e < 8; ++e) ss += hv[e] * hv[e];
            ss += __shfl_xor(ss, 1); ss += __shfl_xor(ss, 2); ss += __shfl_xor(ss, 4); ss += __shfl_xor(ss, 8);
            const float rs = rsqrtf(ss * (1.0f / 128.0f) + EPS);
            const f32x4 g0 = *(const f32x4*)(ng + c), g1 = *(const f32x4*)(ng + c + 4), s0 = *(const f32x4*)(sk + c), s1 = *(const f32x4*)(sk + c + 4);
            float y[8];
#pragma unroll
            for (int e = 0; e < 4; ++e) { y[e] = hv[e] * rs * g0[e] + s0[e] * uf[e]; y[4 + e] = hv[4 + e] * rs * g1[e] + s1[e] * uf[4 + e]; }
            *(bf16x8*)(YB + (size_t)mrow * DM + 512 + c) = pack8(y);
        }
    }
#endif
    GRID_SYNC();
#if (PH_MASK >> 7) & 1
    {
        FRESH_IDS
        pg8::Cfg g{DM, DM, DM, 128, 128}; pg8::Sched2D S; S.init(YB, WTOUT, (size_t)256 * DM * 2, (size_t)256 * DM * 2, M / 256, DM / 256, G, bx);
        EpiOut E{P.in[0], P.out, XN, SSQ};
        pg8::gemm_phase(lds, g, S, E);
    }
#endif
    GRID_SYNC();
#if (PH_MASK >> 8) & 1
    {
        FRESH_IDS
        pg8::Cfg g{DM, DM, DM, 128, 128}; pg8::Sched2D S; S.init(XN, WTGU, (size_t)256 * DM * 2, (size_t)256 * DM * 2, M / 256, 2 * FF / 256, G, bx);
        EpiGU E{PROJ, SSQ};
        pg8::gemm_phase(lds, g, S, E);
    }
#endif
    GRID_SYNC();
#if (PH_MASK >> 9) & 1
    {
        FRESH_IDS
        pg8::Cfg g{FF, FF, FF, 128, 128}; pg8::Sched2D S; S.init(PROJ, WTDN, (size_t)256 * FF * 2, (size_t)256 * FF * 2, M / 256, DM / 256, G, bx);
        EpiDown E{P.out};
        pg8::gemm_phase(lds, g, S, E);
    }
#endif
}

extern "C" void kernel_launch(void* const* d_in, const int* in_sizes, int n_in, void* d_out, int out_size, void* d_ws, size_t ws_size, hipStream_t stream) {
    static int grid = 0;
    if (grid == 0) {
        if (n_in != 25 || out_size != M * DM || ws_size < O_END) { fprintf(stderr, "kernel_launch: unexpected shapes (n_in %d, out %d, ws %zu < %zu)\n", n_in, out_size, ws_size, (size_t)O_END); grid = -1; return; }
        int dev = 0, cus = 0, per_cu = 0;
        hipGetDevice(&dev); hipDeviceGetAttribute(&cus, hipDeviceAttributeMultiprocessorCount, dev);
        if (hipFuncSetAttribute((const void*)fwd_kernel, hipFuncAttributeMaxDynamicSharedMemorySize, LDS_BYTES) != hipSuccess) { fprintf(stderr, "kernel_launch: hipFuncSetAttribute failed\n"); grid = -1; return; }
        if (hipOccupancyMaxActiveBlocksPerMultiprocessor(&per_cu, (const void*)fwd_kernel, 512, LDS_BYTES) != hipSuccess || per_cu < 1) { fprintf(stderr, "kernel_launch: occupancy query gave %d\n", per_cu); (void)hipGetLastError(); grid = -1; return; }
        grid = cus;
    }
    if (grid < 0) return;
    (void)hipMemsetAsync((char*)d_ws + O_CTL, 0, 4096, stream);
    KParams p{};
    for (int i = 0; i < 25; ++i) p.in[i] = (const float*)d_in[i];
    p.out = (float*)d_out; p.ws = (unsigned char*)d_ws;
    void* args[] = {&p};
    hipError_t e = hipLaunchCooperativeKernel((const void*)fwd_kernel, dim3(grid), dim3(512), args, LDS_BYTES, stream);
    if (e != hipSuccess) fprintf(stderr, "cooperative launch failed: %s (grid %d)\n", hipGetErrorString(e), grid);
}
```
